# Optimizing an MI355X kernel written in HIP

```python
import math
import jax, jax.numpy as jnp
from jax import lax
import numpy as np

D_MODEL = 1024
BATCH = 8
SEQ = 4096
DEPTH = 1

HEAD_DIM = 64
N_ATTN_HEADS = 8
ATTN_WIDTH = N_ATTN_HEADS * HEAD_DIM
N_RWKV_HEADS = 8
RWKV_WIDTH = N_RWKV_HEADS * HEAD_DIM
MIX_WIDTH = ATTN_WIDTH + RWKV_WIDTH
RWKV_DECAY_LORA = 32
RWKV_AAA_LORA = 32
RWKV_GATE_LORA = 96
RWKV_SHIFT_WIDTH = 3 * RWKV_WIDTH + RWKV_DECAY_LORA + RWKV_AAA_LORA + RWKV_GATE_LORA
IN_PROJ_WIDTH = 3 * ATTN_WIDTH + RWKV_SHIFT_WIDTH
RWKV_DECAY_SCALE = math.exp(-0.5)
RWKV_GN_EPS = HEAD_DIM * 1e-5
MOBA_BLOCK = 256
MOBA_TOPK = 3
MOBA_QCHUNK = 32
N_EXPERTS = 32
TOP_K = 4
D_EXPERT = D_MODEL
SWIGLU_LIMIT = 7.0
SWIGLU_ALPHA = 1.702
MOE_BLOCK = 256
NORM_EPS = 1e-6
NEG_INF = -1e30

kernel_name = "hymba_moba_rwkv7_gptoss_moe_block"


def rms_norm(x, g):
    xf = x.astype(jnp.float32)
    return xf * lax.rsqrt(jnp.mean(xf * xf, axis=-1, keepdims=True) + NORM_EPS) * g.astype(jnp.float32)


def alibi_slopes(n_heads):
    return 2.0 ** (-8.0 * jnp.arange(1, n_heads + 1, dtype=jnp.float32) / n_heads)


def moba_attention(q, k, v, slopes):
    B, S, H, Dh = q.shape
    Sp = -(-S // MOBA_BLOCK) * MOBA_BLOCK
    pad = ((0, 0), (0, Sp - S), (0, 0), (0, 0))
    q, k, v = [jnp.pad(t, pad).transpose(0, 2, 1, 3) for t in (q, k, v)]
    nb = Sp // MOBA_BLOCK
    n_sel = min(MOBA_TOPK, nb)
    n_chunks = Sp // MOBA_QCHUNK
    kb = k.reshape(B, H, nb, MOBA_BLOCK, Dh)
    vb = v.reshape(B, H, nb, MOBA_BLOCK, Dh)
    k_mean = kb.mean(axis=3)
    q_chunks = q.reshape(B, H, n_chunks, MOBA_QCHUNK, Dh).transpose(2, 0, 1, 3, 4)
    scale = Dh ** -0.5
    b_idx = jnp.arange(B)[:, None, None, None]
    h_idx = jnp.arange(H)[None, :, None, None]
    key_off = jnp.arange(MOBA_BLOCK)

    def attend_chunk(args):
        qq, ci = args
        t = ci * MOBA_QCHUNK + jnp.arange(MOBA_QCHUNK)
        own = (ci * MOBA_QCHUNK) // MOBA_BLOCK
        gate = jnp.einsum('bhqd,bhnd->bhqn', qq, k_mean)
        gate = jnp.where(jnp.arange(nb) < own, gate, NEG_INF)
        _, sel = lax.top_k(gate, n_sel)
        sel_valid = jnp.arange(n_sel) < own
        k_sel = kb[b_idx, h_idx, sel]
        v_sel = vb[b_idx, h_idx, sel]
        pos_sel = sel[..., None] * MOBA_BLOCK + key_off
        dist_sel = (t[None, None, :, None, None] - pos_sel).astype(jnp.float32)
        s_sel = (jnp.einsum('bhqd,bhqnkd->bhqnk', qq, k_sel) * scale
                 - slopes[None, :, None, None, None] * dist_sel)
        s_sel = jnp.where(sel_valid[:, None], s_sel, NEG_INF)
        k_own = lax.dynamic_index_in_dim(kb, own, axis=2, keepdims=False)
        v_own = lax.dynamic_index_in_dim(vb, own, axis=2, keepdims=False)
        pos_own = own * MOBA_BLOCK + key_off
        dist_own = (t[:, None] - pos_own[None, :]).astype(jnp.float32)
        s_own = (jnp.einsum('bhqd,bhkd->bhqk', qq, k_own) * scale
                 - slopes[None, :, None, None] * dist_own[None, None])
        s_own = jnp.where(dist_own >= 0, s_own, NEG_INF)
        scores = jnp.concatenate([s_sel.reshape(B, H, MOBA_QCHUNK, n_sel * MOBA_BLOCK), s_own], axis=-1)
        p = jax.nn.softmax(scores.astype(jnp.float32), axis=-1)
        p_sel = p[..., :n_sel * MOBA_BLOCK].reshape(B, H, MOBA_QCHUNK, n_sel, MOBA_BLOCK)
        p_own = p[..., n_sel * MOBA_BLOCK:]
        return (jnp.einsum('bhqnk,bhqnkd->bhqd', p_sel, v_sel)
                + jnp.einsum('bhqk,bhkd->bhqd', p_own, v_own))

    out = lax.map(attend_chunk, (q_chunks, jnp.arange(n_chunks)))
    out = out.transpose(1, 0, 3, 2, 4).reshape(B, Sp, H, Dh)
    return out[:, :S]


def rwkv7_time_mix(xr, mu, w0, w2, a0, a2, g2, k_k, k_a, r_k, ln_g, ln_b):
    B, S, _ = xr.shape
    H, N = N_RWKV_HEADS, HEAD_DIM
    x_prev = jnp.pad(xr, ((0, 0), (1, 0), (0, 0)))[:, :S]
    xs = xr + (x_prev - xr) * mu
    o1 = RWKV_WIDTH
    o2 = 2 * RWKV_WIDTH
    o3 = 3 * RWKV_WIDTH
    o4 = o3 + RWKV_DECAY_LORA
    o5 = o4 + RWKV_AAA_LORA
    r, k, v, dw, da, dg = jnp.split(xs, [o1, o2, o3, o4, o5], axis=-1)
    w = jnp.exp(-RWKV_DECAY_SCALE * jax.nn.sigmoid(w0 + jnp.tanh(dw) @ w2))
    a = jax.nn.sigmoid(a0 + da @ a2)
    g = jax.nn.sigmoid(dg) @ g2
    heads = lambda t: t.reshape(B, S, H, N)
    kk = heads(k * k_k)
    kk = kk * lax.rsqrt(jnp.maximum(jnp.sum(kk * kk, axis=-1, keepdims=True), 1e-24))
    k = k * (1.0 + (a - 1.0) * k_a)
    r, w, k, v, a = [heads(t) for t in (r, w, k, v, a)]
    b_vec = kk * a
    seq_first = lambda t: t.transpose(1, 0, 2, 3)

    def step(state, inp):
        r_t, w_t, k_t, v_t, kk_t, b_t = inp
        sa = jnp.einsum('bhvk,bhk->bhv', state, -kk_t)
        state = (state * w_t[:, :, None, :] + sa[..., None] * b_t[:, :, None, :]
                 + v_t[..., None] * k_t[:, :, None, :])
        return state, jnp.einsum('bhvk,bhk->bhv', state, r_t)

    state0 = jnp.zeros((B, H, N, N), jnp.float32)
    xs_scan = tuple(seq_first(t.astype(jnp.float32)) for t in (r, w, k, v, kk, b_vec))
    _, o = lax.scan(step, state0, xs_scan)
    o = seq_first(o)
    mean = jnp.mean(o, axis=-1, keepdims=True)
    var = jnp.mean(jnp.square(o - mean), axis=-1, keepdims=True)
    o = ((o - mean) * lax.rsqrt(var + RWKV_GN_EPS)).reshape(B, S, RWKV_WIDTH) * ln_g + ln_b
    bonus = jnp.sum(r * k * r_k, axis=-1, keepdims=True) * v
    return (o + bonus.reshape(B, S, RWKV_WIDTH)) * g


def moe_ffn(xn, w_router, b_router, w_gate, b_gate, w_up, b_up, w_down, b_down):
    T, D = xn.shape
    logits = (xn @ w_router + b_router).astype(jnp.float32)
    top_val, top_idx = lax.top_k(logits, TOP_K)
    gates = jax.nn.softmax(top_val, axis=-1)
    A = T * TOP_K
    e_flat = top_idx.reshape(A)
    tok_flat = jnp.arange(A) // TOP_K
    g_flat = gates.reshape(A)
    order = jnp.argsort(e_flat)
    e_sorted = e_flat[order]
    tok_sorted = tok_flat[order]
    g_sorted = g_flat[order]
    counts = jnp.bincount(e_flat, length=N_EXPERTS)
    padded = ((counts + MOE_BLOCK - 1) // MOE_BLOCK) * MOE_BLOCK
    pad_end = jnp.cumsum(padded)
    pad_start = pad_end - padded
    grp_start = jnp.cumsum(counts) - counts
    dest = pad_start[e_sorted] + (jnp.arange(A) - grp_start[e_sorted])
    n_blocks = -(-A // MOE_BLOCK) + N_EXPERTS
    P = n_blocks * MOE_BLOCK
    slot_tok = jnp.full((P,), T, dtype=jnp.int32).at[dest].set(tok_sorted.astype(jnp.int32))
    block_expert = jnp.minimum(
        jnp.searchsorted(pad_end, jnp.arange(n_blocks) * MOE_BLOCK, side='right'), N_EXPERTS - 1)
    x_pad = jnp.concatenate([xn, jnp.zeros((1, D), xn.dtype)], axis=0)

    def expert_block(args):
        toks, e = args
        h = x_pad[toks]
        gate = jnp.minimum(h @ w_gate[e] + b_gate[e], SWIGLU_LIMIT)
        up = jnp.clip(h @ w_up[e] + b_up[e], -SWIGLU_LIMIT, SWIGLU_LIMIT)
        glu = gate * jax.nn.sigmoid(SWIGLU_ALPHA * gate)
        return ((up + 1.0) * glu) @ w_down[e] + b_down[e]

    y_slots = lax.map(expert_block, (slot_tok.reshape(n_blocks, MOE_BLOCK), block_expert)).reshape(P, D)
    return jax.ops.segment_sum(y_slots[dest] * g_sorted[:, None], tok_sorted, num_segments=T)


def setup_inputs(seed: int = 0) -> dict:
    key = jax.random.key(seed)
    ks = jax.random.split(key, 32)
    L, D, E, F = DEPTH, D_MODEL, N_EXPERTS, D_EXPERT
    nrm = lambda k, shape, s: jax.random.normal(k, shape, jnp.float32) * s
    return {
        "x": nrm(ks[0], (BATCH, SEQ, D), 1.0),
        "norm_mix_g": 1.0 + nrm(ks[1], (L, D), 0.05),
        "w_in": nrm(ks[2], (L, D, IN_PROJ_WIDTH), D ** -0.5),
        "attn_norm_g": 1.0 + nrm(ks[3], (L, ATTN_WIDTH), 0.05),
        "rwkv_mu": jax.random.uniform(ks[4], (L, RWKV_SHIFT_WIDTH), jnp.float32),
        "rwkv_w0": nrm(ks[5], (L, RWKV_WIDTH), 0.5),
        "rwkv_w2": nrm(ks[6], (L, RWKV_DECAY_LORA, RWKV_WIDTH), 0.1),
        "rwkv_a0": nrm(ks[7], (L, RWKV_WIDTH), 0.1),
        "rwkv_a2": nrm(ks[8], (L, RWKV_AAA_LORA, RWKV_WIDTH), 0.1),
        "rwkv_g2": nrm(ks[9], (L, RWKV_GATE_LORA, RWKV_WIDTH), RWKV_GATE_LORA ** -0.5),
        "rwkv_k_k": 0.85 + nrm(ks[10], (L, RWKV_WIDTH), 0.05),
        "rwkv_k_a": 1.0 + nrm(ks[11], (L, RWKV_WIDTH), 0.05),
        "rwkv_r_k": nrm(ks[12], (L, N_RWKV_HEADS, HEAD_DIM), 0.1),
        "rwkv_ln_g": 1.0 + nrm(ks[13], (L, RWKV_WIDTH), 0.05),
        "rwkv_ln_b": nrm(ks[14], (L, RWKV_WIDTH), 0.01),
        "w_out": nrm(ks[15], (L, MIX_WIDTH, D), MIX_WIDTH ** -0.5),
        "norm_ffn_g": 1.0 + nrm(ks[16], (L, D), 0.05),
        "w_router": nrm(ks[17], (L, D, E), D ** -0.5),
        "b_router": nrm(ks[18], (L, E), 0.01),
        "moe_w_gate": nrm(ks[19], (L, E, D, F), D ** -0.5),
        "moe_b_gate": nrm(ks[20], (L, E, F), 0.01),
        "moe_w_up": nrm(ks[21], (L, E, D, F), D ** -0.5),
        "moe_b_up": nrm(ks[22], (L, E, F), 0.01),
        "moe_w_down": nrm(ks[23], (L, E, F, D), F ** -0.5),
        "moe_b_down": nrm(ks[24], (L, E, D), 0.01),
        "norm_final_g": 1.0 + nrm(ks[25], (D,), 0.05),
    }


def reference(x, norm_mix_g, w_in, attn_norm_g, rwkv_mu, rwkv_w0, rwkv_w2, rwkv_a0, rwkv_a2,
              rwkv_g2, rwkv_k_k, rwkv_k_a, rwkv_r_k, rwkv_ln_g, rwkv_ln_b, w_out, norm_ffn_g,
              w_router, b_router, moe_w_gate, moe_b_gate, moe_w_up, moe_b_up, moe_w_down,
              moe_b_down, norm_final_g):
    B, S, D = x.shape
    slopes = alibi_slopes(N_ATTN_HEADS)
    h = x.astype(jnp.float32)
    for l in range(DEPTH):
        xn = rms_norm(h, norm_mix_g[l])
        proj = xn @ w_in[l]
        q = proj[..., :ATTN_WIDTH].reshape(B, S, N_ATTN_HEADS, HEAD_DIM)
        k = proj[..., ATTN_WIDTH:2 * ATTN_WIDTH].reshape(B, S, N_ATTN_HEADS, HEAD_DIM)
        v = proj[..., 2 * ATTN_WIDTH:3 * ATTN_WIDTH].reshape(B, S, N_ATTN_HEADS, HEAD_DIM)
        o_att = moba_attention(q, k, v, slopes)
        o_att = o_att * lax.rsqrt(jnp.mean(o_att * o_att, axis=-1, keepdims=True) + NORM_EPS)
        o_att = o_att.reshape(B, S, ATTN_WIDTH) * attn_norm_g[l]
        o_rwkv = rwkv7_time_mix(proj[..., 3 * ATTN_WIDTH:], rwkv_mu[l], rwkv_w0[l], rwkv_w2[l],
                                rwkv_a0[l], rwkv_a2[l], rwkv_g2[l], rwkv_k_k[l], rwkv_k_a[l],
                                rwkv_r_k[l], rwkv_ln_g[l], rwkv_ln_b[l])
        h = h + jnp.concatenate([o_att, o_rwkv], axis=-1) @ w_out[l]
        xn2 = rms_norm(h, norm_ffn_g[l]).reshape(B * S, D)
        y = moe_ffn(xn2, w_router[l], b_router[l], moe_w_gate[l], moe_b_gate[l],
                    moe_w_up[l], moe_b_up[l], moe_w_down[l], moe_b_down[l])
        h = h + y.reshape(B, S, D)
    return rms_norm(h, norm_final_g).astype(x.dtype)
```

```cpp
#define REPMASK 0
#include <hip/hip_runtime.h>
#include <cstdio>
#include <cstdint>
namespace pg8 {
#define PG8_LAS __attribute__((address_space(3)))
typedef unsigned short bf16_t;
typedef short bf16x8 __attribute__((ext_vector_type(8)));
typedef float f32x4 __attribute__((ext_vector_type(4)));
typedef float f32x2 __attribute__((ext_vector_type(2)));
typedef unsigned u32x4 __attribute__((ext_vector_type(4)));
typedef unsigned u32x2 __attribute__((ext_vector_type(2)));
constexpr int BM = 256, BK = 64, HALF = 128, HTB = HALF * BK * 2, STAGE_BYTES = 8 * HTB, NXCD = 8, WGM = 8;

__host__ __device__ __forceinline__ int lds_byte(int r, int c) { const int st = (r >> 4) * 2 + (c >> 5), rr = r & 15, cc = c & 31, ob = rr * 64 + cc * 2; return st * 1024 + (ob ^ (((ob >> 9) & 1) << 5)); }
__host__ __device__ __forceinline__ void stage_rc(int b, int& R, int& C) { const int st = b / 1024, sb = b % 1024, swz = sb ^ (((sb >> 9) & 1) << 5); R = (st >> 1) * 16 + swz / 64; C = (st & 1) * 32 + (swz % 64) / 2; }
__host__ __device__ __forceinline__ int perm32(int rho) { const int n = rho >> 4, i = rho & 15; return 8 * (i >> 2) + 4 * n + (i & 3); }
typedef float f32x2c_t __attribute__((ext_vector_type(2))); typedef __bf16 bf16x2c_t __attribute__((ext_vector_type(2)));
__device__ __forceinline__ unsigned cvt_pk_bf16(float lo, float hi) { f32x2c_t v = {lo, hi}; bf16x2c_t b = __builtin_convertvector(v, bf16x2c_t); return __builtin_bit_cast(unsigned, b); }

__device__ __forceinline__ void glds4(const void* gsrc, unsigned lds_base) { unsigned keep;
    asm volatile("s_mov_b32 %0, m0\n\ts_mov_b32 m0, %2\n\ts_nop 0\n\tglobal_load_lds_dword %1, off\n\ts_mov_b32 m0, %0" : "=&s"(keep) : "v"(gsrc), "s"(lds_base) : "memory"); }

struct Unit { int arow0; int brow0; int orow0; int ocol0; int e; int cnt; const int* rows; int idx; };
struct Gemm { const bf16_t* A; const bf16_t* Bt; int K; int lda; };

struct DenseOrder {
    int nM, nN, nwg, G, c;
    __device__ void init(int M, int N, int G_, int c_) { nM = M / BM; nN = N / BM; nwg = nM * nN; G = G_; c = c_; }
    __device__ __forceinline__ bool next(int i, Unit& u) const {
        const long L = (long)i * G + c; if (L >= nwg) return false;
        int wgid = (int)L; { const int q = nwg / NXCD, r = nwg % NXCD, xcd = wgid % NXCD, off = wgid / NXCD; wgid = (xcd < r ? xcd * (q + 1) : r * (q + 1) + (xcd - r) * q) + off; }
        const int nig = WGM * nN, gid = wgid / nig, fm = gid * WGM, gsz = (nM - fm) < WGM ? (nM - fm) : WGM;
        const int pm = fm + ((wgid % nig) % gsz), pn = (wgid % nig) / gsz;
        u.arow0 = pm * BM; u.brow0 = pn * BM; u.orow0 = pm * BM; u.ocol0 = pn * BM; u.e = 0; u.cnt = BM; u.rows = nullptr; u.idx = i; return true;
    }
};

struct RowMajorOrder {
    int nwg, nN, G, c;
    __device__ __forceinline__ bool next(int i, Unit& u) const { const int L = i * G + c; if (L >= nwg) return false; const int pm = L / nN, pn = L - pm * nN;
        u.arow0 = pm * BM; u.brow0 = pn * BM; u.orow0 = pm * BM; u.ocol0 = pn * BM; u.e = 0; u.cnt = BM; u.rows = nullptr; u.idx = i; return true; }
};

template <class Epi, class Sched, bool GATHER, bool FP8 = false>
__device__ __forceinline__ void gemm_phase(PG8_LAS unsigned char* lds, const Gemm g, const Sched& S, const Epi& E) {
    const int tid = threadIdx.x, wid = __builtin_amdgcn_readfirstlane(tid >> 6), lane = tid & 63, wr = wid >> 2, wc = wid & 3, fr = lane & 15, fq = lane >> 4;
    const int KB = FP8 ? g.K : g.K * 2, nt = KB / (BK * 2);
    unsigned voffB[2];
    unsigned vA0[2], vA1[2];
#pragma unroll
    for (int i = 0; i < 2; ++i) { int R, C; stage_rc(tid * 16 + i * 8192, R, C); const int Rb = Epi::PERM ? ((R & ~31) + perm32(R & 31)) : R;
        voffB[i] = (unsigned)(Rb * KB + C * 2); }
    const size_t kstep = (size_t)(BK * 2);
    const size_t hstep = (size_t)HALF * KB;
    const unsigned ldsw = (unsigned)wid * 1024u;
    const int aoff = lds_byte(wr * 64 + fr, fq * 8), boff = lds_byte(wc * 32 + fr, fq * 8);
#define PG8_SA(b, h) (((b) * 2 + (h)) * HTB)
#define PG8_SB(b, h) ((4 + (b) * 2 + (h)) * HTB)
#define PG8_STAGE(bufoff, gbase, voff) do { _Pragma("unroll") for (int _i = 0; _i < 2; ++_i) \
        __builtin_amdgcn_global_load_lds((const unsigned*)((const char*)(gbase) + (voff)[_i]), (PG8_LAS unsigned*)(lds + (bufoff) + ldsw + _i * 8192), 16, 0, 0); } while (0)
#define PG8_LDA(dst, b, h) do { _Pragma("unroll") for (int m = 0; m < 4; ++m) _Pragma("unroll") for (int k = 0; k < 2; ++k) dst[m][k] = *(const PG8_LAS bf16x8*)(lds + PG8_SA(b, h) + aoff + m * 2048 + k * 1024); } while (0)
#define PG8_LDB(dst, b, h) do { _Pragma("unroll") for (int n = 0; n < 2; ++n) _Pragma("unroll") for (int k = 0; k < 2; ++k) dst[n][k] = *(const PG8_LAS bf16x8*)(lds + PG8_SB(b, h) + boff + n * 2048 + k * 1024); } while (0)
#define PG8_MMA(ai, bj, At, Bt) do { __builtin_amdgcn_s_setprio(1); _Pragma("unroll") for (int m = 0; m < 4; ++m) _Pragma("unroll") for (int n = 0; n < 2; ++n) { \
        if constexpr (FP8) { typedef int v8i_ __attribute__((ext_vector_type(8))); typedef int v4i_ __attribute__((ext_vector_type(4))); \
            const v4i_ b0_ = __builtin_bit_cast(v4i_, Bt[n][0]), b1_ = __builtin_bit_cast(v4i_, Bt[n][1]), a0_ = __builtin_bit_cast(v4i_, At[m][0]), a1_ = __builtin_bit_cast(v4i_, At[m][1]); \
            acc[ai][bj][m][n] = __builtin_amdgcn_mfma_scale_f32_16x16x128_f8f6f4((v8i_){b0_.x, b0_.y, b0_.z, b0_.w, b1_.x, b1_.y, b1_.z, b1_.w}, (v8i_){a0_.x, a0_.y, a0_.z, a0_.w, a1_.x, a1_.y, a1_.z, a1_.w}, acc[ai][bj][m][n], 0, 0, 0, 0x7f7f7f7f, 0, 0x7f7f7f7f); } \
        else { _Pragma("unroll") for (int k = 0; k < 2; ++k) acc[ai][bj][m][n] = __builtin_amdgcn_mfma_f32_16x16x32_bf16(Bt[n][k], At[m][k], acc[ai][bj][m][n], 0, 0, 0); } } \
        __builtin_amdgcn_s_setprio(0); } while (0)
#define PG8_WAIT_V(n) asm volatile("s_waitcnt vmcnt(" #n ")" ::: "memory")
#define PG8_WAIT_L(n) asm volatile("s_waitcnt lgkmcnt(" #n ")" ::: "memory")
#define PG8_BAR __builtin_amdgcn_s_barrier()
#define PG8_SCHED __builtin_amdgcn_sched_barrier(0)
#define PG8_LOADROWS(U, g0, g1) do { _Pragma("unroll") for (int _i = 0; _i < 2; ++_i) { int R_, C_; stage_rc(tid * 16 + _i * 8192, R_, C_); \
        if constexpr (GATHER) { g0[_i] = (R_ < (U).cnt) ? (U).rows[R_] : 0; g1[_i] = (R_ + HALF < (U).cnt) ? (U).rows[R_ + HALF] : 0; } \
        else { g0[_i] = (U).arow0 + R_; g1[_i] = (U).arow0 + R_ + HALF; } } } while (0)
#define PG8_SETA(g0, g1) do { _Pragma("unroll") for (int _i = 0; _i < 2; ++_i) { int R_, C_; stage_rc(tid * 16 + _i * 8192, R_, C_); \
        vA0[_i] = (unsigned)g0[_i] * (unsigned)g.lda + (unsigned)(C_ * 2); vA1[_i] = (unsigned)g1[_i] * (unsigned)g.lda + (unsigned)(C_ * 2); } } while (0)
    Unit cur, nxt; int ui = 0;
    if (!S.next(0, cur)) return;
    f32x4 acc[2][2][4][2];
#pragma unroll
    for (int a = 0; a < 2; ++a)
#pragma unroll
        for (int b = 0; b < 2; ++b)
#pragma unroll
            for (int m = 0; m < 4; ++m)
#pragma unroll
                for (int n = 0; n < 2; ++n) acc[a][b][m][n] = (f32x4){0.f, 0.f, 0.f, 0.f};
    bf16x8 At[4][2], B0[2][2], B1[2][2];
    const char* const Ab = (const char*)g.A;
    const char* cB = (const char*)g.Bt + (size_t)cur.brow0 * KB;
    { int g0[2], g1[2]; PG8_LOADROWS(cur, g0, g1); PG8_SETA(g0, g1); }
    PG8_STAGE(PG8_SB(0, 0), cB, voffB); PG8_STAGE(PG8_SB(0, 1), cB + hstep, voffB); PG8_STAGE(PG8_SA(0, 0), Ab, vA0); PG8_STAGE(PG8_SA(0, 1), Ab, vA1);
    if (wr == 1) PG8_BAR;
    PG8_WAIT_V(2); PG8_BAR;
    PG8_STAGE(PG8_SB(1, 0), cB + kstep, voffB); PG8_STAGE(PG8_SA(1, 0), Ab + kstep, vA0); PG8_STAGE(PG8_SB(1, 1), cB + hstep + kstep, voffB);
    PG8_WAIT_V(6); PG8_BAR;
    for (;;) {
        const bool has_next = S.next(ui + 1, nxt);
        const char* nB = has_next ? (const char*)g.Bt + (size_t)nxt.brow0 * KB : cB;
        for (int t = 0; t < nt; t += 2) {
            const bool last = (t == nt - 2);
            if constexpr (GATHER) { if (t == nt - 4 && has_next && wid < 4)
                glds4(nxt.rows + wid * 64 + lane, (unsigned)__builtin_amdgcn_readfirstlane((unsigned)(uintptr_t)(lds + STAGE_BYTES + 2048) + wid * 256)); }
            const char* a1 = Ab + (size_t)(t + 1) * kstep;
            const char* a2 = last ? Ab : Ab + (size_t)(t + 2) * kstep; const char* b2 = last ? nB : cB + (size_t)(t + 2) * kstep;
            const char* a3 = a2 + kstep; const char* b3 = b2 + kstep;
            PG8_LDB(B0, 0, 0); PG8_LDB(B1, 0, 1); PG8_SCHED; PG8_LDA(At, 0, 0); PG8_STAGE(PG8_SA(1, 1), a1, vA1);
            PG8_WAIT_V(8); PG8_WAIT_L(0); PG8_BAR; PG8_MMA(0, 0, At, B0); PG8_MMA(0, 1, At, B1); PG8_BAR; PG8_SCHED;
            if (last && has_next) {
                int g0[2], g1[2];
                if constexpr (GATHER) { int R0_, C0_; stage_rc(tid * 16, R0_, C0_); const PG8_LAS int* rl_ = (const PG8_LAS int*)(lds + STAGE_BYTES + 2048) + R0_;
                    const int a_ = rl_[0], b_ = rl_[64], c_ = rl_[128], d_ = rl_[192]; const int cn_ = nxt.cnt;
                    g0[0] = (R0_ < cn_) ? a_ : 0; g0[1] = (R0_ + 64 < cn_) ? b_ : 0; g1[0] = (R0_ + 128 < cn_) ? c_ : 0; g1[1] = (R0_ + 192 < cn_) ? d_ : 0; }
                else { PG8_LOADROWS(nxt, g0, g1); }
                PG8_SETA(g0, g1); }
            PG8_LDA(At, 0, 1); PG8_STAGE(PG8_SB(0, 0), b2, voffB); PG8_STAGE(PG8_SB(0, 1), b2 + hstep, voffB); PG8_STAGE(PG8_SA(0, 0), a2, vA0);
            PG8_WAIT_V(8); PG8_WAIT_L(0); PG8_BAR; PG8_MMA(1, 0, At, B0); PG8_MMA(1, 1, At, B1); PG8_BAR; PG8_SCHED;
            PG8_LDB(B0, 1, 0); PG8_LDB(B1, 1, 1); PG8_SCHED; PG8_LDA(At, 1, 0); PG8_STAGE(PG8_SA(0, 1), a2, vA1);
            PG8_WAIT_V(8); PG8_WAIT_L(0); PG8_BAR; PG8_MMA(0, 0, At, B0); PG8_MMA(0, 1, At, B1); PG8_BAR; PG8_SCHED;
            PG8_LDA(At, 1, 1); PG8_STAGE(PG8_SB(1, 0), b3, voffB); PG8_STAGE(PG8_SB(1, 1), b3 + hstep, voffB); PG8_STAGE(PG8_SA(1, 0), a3, vA0);
            PG8_WAIT_V(8); PG8_WAIT_L(0); PG8_BAR; PG8_MMA(1, 0, At, B0); PG8_MMA(1, 1, At, B1); PG8_BAR; PG8_SCHED;
        }
        if (wr == 0) PG8_BAR;
        E(acc, cur, wr, wc, fr, fq);
        if (!has_next) break;
#pragma unroll
        for (int a = 0; a < 2; ++a)
#pragma unroll
            for (int b = 0; b < 2; ++b)
#pragma unroll
                for (int m = 0; m < 4; ++m)
#pragma unroll
                    for (int n = 0; n < 2; ++n) acc[a][b][m][n] = (f32x4){0.f, 0.f, 0.f, 0.f};
        cur = nxt; cB = nB; ++ui;
        if (wr == 1) PG8_BAR;
    }
    PG8_WAIT_V(0);
    PG8_BAR;
#undef PG8_SA
#undef PG8_SB
#undef PG8_STAGE
#undef PG8_LDA
#undef PG8_LDB
#undef PG8_MMA
#undef PG8_WAIT_V
#undef PG8_WAIT_L
#undef PG8_BAR
#undef PG8_SCHED
#undef PG8_SETA
#undef PG8_LOADROWS
}
}
constexpr int D_MODEL = 1024, BATCH = 8, SEQ = 4096, T_TOK = BATCH * SEQ;
constexpr int HD = 64, NH = 8, ATTN_W = 512, RWKV_W = 512;
constexpr int LORA_W = 32, LORA_A = 32, LORA_G = 96;
constexpr int XR_W = 3 * RWKV_W + LORA_W + LORA_A + LORA_G;
constexpr int INW = 3 * ATTN_W + XR_W;
constexpr int INW_PAD = 3328;
constexpr int XR_OFF = 3 * ATTN_W;
constexpr int NEXP = 32, TOPK = 4, NASSIGN = T_TOK * TOPK;
constexpr int MAX_TILES = NASSIGN / 256 + NEXP;
constexpr float NORM_EPS = 1e-6f;
constexpr float DECAY_SCALE = 0.6065306597126334f;
constexpr float GN_EPS = 64e-5f;
constexpr int NWAVES = 8, NTHREADS = 512;

#define GAS __attribute__((address_space(1)))
#define LAS __attribute__((address_space(3)))
typedef unsigned short bf16;
typedef unsigned v4u __attribute__((ext_vector_type(4)));
typedef unsigned v2u __attribute__((ext_vector_type(2)));
typedef float f32x4 __attribute__((ext_vector_type(4)));
typedef float f32x2 __attribute__((ext_vector_type(2)));
typedef short bf16x8 __attribute__((ext_vector_type(8)));
#define RLX_AGENT __ATOMIC_RELAXED, __HIP_MEMORY_SCOPE_AGENT
#define LDS_WAIT() asm volatile("s_waitcnt lgkmcnt(0)" ::: "memory")
#define VM_WAIT() asm volatile("s_waitcnt vmcnt(0)" ::: "memory")
__device__ __forceinline__ unsigned f2bf(float f) { unsigned u = __builtin_bit_cast(unsigned, f); return (u + 0x7fffu + ((u >> 16) & 1u)) >> 16; }
__device__ __forceinline__ unsigned pk2(float lo, float hi) { return f2bf(lo) | (f2bf(hi) << 16); }
__device__ __forceinline__ float bf2f(unsigned short b) { return __builtin_bit_cast(float, ((unsigned)b) << 16); }
__device__ __forceinline__ float bflo(unsigned w) { return __builtin_bit_cast(float, w << 16); }
__device__ __forceinline__ float bfhi(unsigned w) { return __builtin_bit_cast(float, w & 0xffff0000u); }
__device__ __forceinline__ float wave_sum(float v) {
#pragma unroll
    for (int o = 1; o < 64; o <<= 1) v += __shfl_xor(v, o);
    return v;
}
__device__ __forceinline__ float wave_sum_dpp(float v) {
    v += __builtin_bit_cast(float, __builtin_amdgcn_update_dpp(0, __builtin_bit_cast(int, v), 0xB1, 0xf, 0xf, false));
    v += __builtin_bit_cast(float, __builtin_amdgcn_update_dpp(0, __builtin_bit_cast(int, v), 0x4E, 0xf, 0xf, false));
    v += __builtin_bit_cast(float, __builtin_amdgcn_update_dpp(0, __builtin_bit_cast(int, v), 0x141, 0xf, 0xf, false));
    v += __builtin_bit_cast(float, __builtin_amdgcn_update_dpp(0, __builtin_bit_cast(int, v), 0x140, 0xf, 0xf, false));
    const int vi = __builtin_bit_cast(int, v);
    return (__builtin_bit_cast(float, __builtin_amdgcn_readlane(vi, 0)) + __builtin_bit_cast(float, __builtin_amdgcn_readlane(vi, 16))) + (__builtin_bit_cast(float, __builtin_amdgcn_readlane(vi, 32)) + __builtin_bit_cast(float, __builtin_amdgcn_readlane(vi, 48)));
}
__device__ __forceinline__ float sigmoidf_(float x) { return 1.0f / (1.0f + __expf(-x)); }

constexpr size_t MiB = 1u << 20;
constexpr size_t WS_CTL = 0, CTL_ZERO_BYTES = 1 * MiB;
constexpr size_t WS_TAB = 1 * MiB;
constexpr size_t TAB_TOPE = 0;
constexpr size_t TAB_TOPG = TAB_TOPE + (size_t)NASSIGN * 4;
constexpr size_t TAB_SLOTOF = TAB_TOPG + (size_t)NASSIGN * 4;
constexpr size_t TAB_SLOTTOK = TAB_SLOTOF + (size_t)NASSIGN * 4;
constexpr size_t TAB_SLOTG = TAB_SLOTTOK + (size_t)(NASSIGN + 256) * 4;
constexpr size_t TAB_WGCNT = TAB_SLOTG + (size_t)(NASSIGN + 256) * 4;
constexpr size_t TAB_TILES = TAB_WGCNT + 256 * 32 * 4;
constexpr size_t TAB_KMEAN = TAB_TILES + (size_t)(MAX_TILES + 1) * 16;
constexpr size_t TAB_BONUS = TAB_KMEAN + (size_t)BATCH * NH * 16 * 64 * 4;
constexpr size_t TAB_END = TAB_BONUS + (size_t)T_TOK * 8 * 4;
static_assert(TAB_END <= 5 * MiB, "tables");
constexpr size_t WS_GU = 6 * MiB;
constexpr size_t WS_BB = WS_GU + 128 * MiB;
constexpr size_t WS_WD = WS_BB + 64 * MiB;
constexpr size_t WS_R3 = WS_WD + 64 * MiB;
constexpr size_t WS_PROJ = WS_R3;
constexpr size_t WS_WIN = WS_PROJ + (size_t)T_TOK * INW_PAD * 2;
constexpr size_t WS_WOUT = WS_WIN + (size_t)INW_PAD * 1024 * 2;
constexpr size_t WS_RW = WS_WOUT + (size_t)1024 * 1024 * 2;
constexpr size_t WS_H = WS_R3;
constexpr size_t WS_GUF = WS_BB;
constexpr size_t WS_WDF = WS_R3 + 225 * MiB;
constexpr size_t WS_ROUT = WS_R3 + 218 * MiB;
constexpr size_t WS_Y = WS_GU;
constexpr size_t WS_END = WS_R3 + 257 * MiB;
constexpr int Y_SPLIT_TILES = 320, Y_SPLIT_ROWS = Y_SPLIT_TILES * 256;
static_assert(WS_END <= 520 * MiB, "ws map");
#define XB_TMO      128
#define XB_XCNT(j)  (256  + 64 * (j))
#define XB_XSUB(j)  (1280 + 64 * (j))
#define XB_XGEN(j)  (2304 + 64 * (j))
#define XB_TOP      3328
#define XB_TOPGEN   3392
#define XCD_BAR_WORDS 3456
#define XB_SPIN_CAP (1u << 22)
__device__ __forceinline__ unsigned xb_ld(unsigned* p)              { return __hip_atomic_load(p, __ATOMIC_RELAXED, __HIP_MEMORY_SCOPE_AGENT); }
__device__ __forceinline__ unsigned xb_add(unsigned* p, unsigned v) { return __hip_atomic_fetch_add(p, v, __ATOMIC_RELAXED, __HIP_MEMORY_SCOPE_AGENT); }
__device__ __forceinline__ unsigned xb_xcc_id() { return (unsigned)__builtin_amdgcn_s_getreg((3 << 11) | 20) & 0xFu; }
#define XB_SPIN(cond, bar) do { unsigned _sp = 0; while (cond) { __builtin_amdgcn_s_sleep(1); \
    if ((++_sp & 255u) == 0u) { if (xb_ld(&(bar)[XB_TMO])) break; if (_sp > XB_SPIN_CAP) { atomicAdd(&(bar)[XB_TMO], 1u); break; } } } } while (0)
struct XcdBarrier { unsigned* bar; unsigned x; volatile LAS unsigned* st; };
__device__ __forceinline__ XcdBarrier xcd_barrier_post(unsigned* bar, volatile LAS unsigned* st) {
    XcdBarrier b; b.bar = bar; b.x = xb_xcc_id(); b.st = st;
    if (threadIdx.x == 0) (void)xb_add(&bar[XB_XCNT(b.x)], 1u);
    return b;
}
__device__ __forceinline__ void xcd_barrier_complete(unsigned* bar, unsigned x, unsigned& nloc, unsigned& nx) {
    const unsigned G = gridDim.x * gridDim.y * gridDim.z;
    unsigned sum, cnt, mine, sp = 0u;
    for (;;) {
        sum = 0u; cnt = 0u; mine = 0u;
#pragma unroll
        for (unsigned j = 0; j < 16; ++j) { const unsigned c = xb_ld(&bar[XB_XCNT(j)]); sum += c; cnt += (c > 0u) ? 1u : 0u; mine = (j == x) ? c : mine; }
        if (sum == G) break;
        __builtin_amdgcn_s_sleep(1);
        if ((++sp & 255u) == 0u) { if (xb_ld(&bar[XB_TMO])) break; if (sp > XB_SPIN_CAP) { atomicAdd(&bar[XB_TMO], 1u); break; } }
    }
    nloc = mine > 0u ? mine : 1u; nx = cnt > 0u ? cnt : 1u;
}
__device__ __forceinline__ void xcd_barrier(const XcdBarrier& b) {
    asm volatile("s_waitcnt vmcnt(0)" ::: "memory");
    __syncthreads();
    if (threadIdx.x == 0) {
        unsigned* bar = b.bar;
        __builtin_amdgcn_s_waitcnt(0);
        unsigned nloc = b.st[0], nx = b.st[1];
        if (nloc == 0u) { xcd_barrier_complete(bar, b.x, nloc, nx); b.st[0] = nloc; b.st[1] = nx; }
        const unsigned old = xb_add(&bar[XB_XSUB(b.x)], 1u);
        const unsigned gen = old / nloc;
        if (old + 1u == (gen + 1u) * nloc) {
            __builtin_amdgcn_fence(__ATOMIC_RELEASE, "agent");
            asm volatile("s_waitcnt vmcnt(0)" ::: "memory");
            const unsigned og = xb_add(&bar[XB_TOP], 1u);
            const unsigned tg = og / nx;
            if (og + 1u == (tg + 1u) * nx) xb_add(&bar[XB_TOPGEN], 1u);
            else XB_SPIN(xb_ld(&bar[XB_TOPGEN]) == tg, bar);
            __builtin_amdgcn_fence(__ATOMIC_ACQUIRE, "agent");
            xb_add(&bar[XB_XGEN(b.x)], 1u);
            asm volatile("s_waitcnt vmcnt(0)" ::: "memory");
        } else {
            XB_SPIN(xb_ld(&bar[XB_XGEN(b.x)]) == gen, bar);
            __builtin_amdgcn_fence(__ATOMIC_ACQUIRE, "agent");
            asm volatile("s_waitcnt vmcnt(0)" ::: "memory");
        }
    }
    __syncthreads();
}

constexpr int RING_OFF = 0, RING_BYTES = 131072;
constexpr int LDSCTL_OFF = RING_BYTES, MISC_OFF = LDSCTL_OFF + 320;
constexpr int LDS_BYTES = 147456;

struct Args { const float* in[26]; float* out; unsigned char* ws; int ph_lo, ph_hi; };
struct Frame {
    LAS unsigned char* lds;
    volatile LAS unsigned* MISC;
    unsigned* ctl;
    int tid, lane, wave;
    int vcu, G;
    unsigned char* ws;
    float* out;
};
__device__ __forceinline__ void p0_transpose_item(const float* W, int N, bf16* WT, int KT, int k0, int n0, int drow0, LAS float* scr, int lane) {
    float t_[32];
#pragma unroll
    for (int i = 0; i < 32; ++i) { const int kk = 2 * i + (lane >> 5); t_[i] = W[(size_t)(k0 + kk) * N + n0 + (lane & 31)]; }
#pragma unroll
    for (int i = 0; i < 32; ++i) { const int kk = 2 * i + (lane >> 5); scr[kk * 33 + (lane & 31)] = t_[i]; }
    LDS_WAIT(); asm volatile("" ::: "memory");
    const int c = lane & 7;
#pragma unroll
    for (int j = 0; j < 4; ++j) { const int n = (lane >> 3) + 8 * j; const LAS float* s = scr + (8 * c) * 33 + n;
        v4u o; o.x = pk2(s[0 * 33], s[1 * 33]); o.y = pk2(s[2 * 33], s[3 * 33]); o.z = pk2(s[4 * 33], s[5 * 33]); o.w = pk2(s[6 * 33], s[7 * 33]);
        *(GAS v4u*)(WT + (size_t)(drow0 + n) * KT + k0 + 8 * c) = o; }
    LDS_WAIT(); asm volatile("" ::: "memory");
}
__device__ __forceinline__ unsigned pk4_fp8(float a, float b, float c, float d) { int w = 0; w = __builtin_amdgcn_cvt_pk_fp8_f32(a, b, w, false); w = __builtin_amdgcn_cvt_pk_fp8_f32(c, d, w, true); return (unsigned)w; }
constexpr float WSCALE = 32.0f, WSCALE_INV = 1.0f / 32.0f;
constexpr float YSCALE = 16.0f, YSCALE_INV = 1.0f / 16.0f;
__device__ __forceinline__ void p0_transpose_item_fp8(const float* W, int N, unsigned char* WT, int KT, int k0, int n0, int drow0, LAS float* scr, int lane) {
#pragma unroll 8
    for (int i = 0; i < 32; ++i) { const int kk = 2 * i + (lane >> 5); scr[kk * 33 + (lane & 31)] = W[(size_t)(k0 + kk) * N + n0 + (lane & 31)]; }
    LDS_WAIT(); asm volatile("" ::: "memory");
    const int n = lane >> 1, hf = lane & 1; const LAS float* s = scr + (32 * hf) * 33 + n;
    unsigned w[8];
#pragma unroll
    for (int q = 0; q < 8; ++q) w[q] = pk4_fp8(s[(4 * q) * 33] * WSCALE, s[(4 * q + 1) * 33] * WSCALE, s[(4 * q + 2) * 33] * WSCALE, s[(4 * q + 3) * 33] * WSCALE);
    GAS v4u* dst = (GAS v4u*)(WT + (size_t)(drow0 + n) * KT + k0 + 32 * hf);
    dst[0] = (v4u){w[0], w[1], w[2], w[3]}; dst[1] = (v4u){w[4], w[5], w[6], w[7]};
    LDS_WAIT(); asm volatile("" ::: "memory");
}
__device__ __forceinline__ void conv_item_fp8(const float* W, unsigned char* WT, int k0, int n0, int drow0, int lane) {
    const int kq = lane >> 4, nq = lane & 15;
    const float* src = W + (size_t)(k0 + 16 * kq) * 1024 + n0 + 4 * nq; f32x4 v[16];
#pragma unroll
    for (int i = 0; i < 16; ++i) v[i] = *(const f32x4*)(src + (size_t)i * 1024) * WSCALE;
    unsigned char* dst = WT + (size_t)(drow0 + 4 * nq) * 1024 + k0 + 16 * kq;
#pragma unroll
    for (int j = 0; j < 4; ++j) *(GAS v4u*)(dst + (size_t)j * 1024) = (v4u){pk4_fp8(v[0][j], v[1][j], v[2][j], v[3][j]), pk4_fp8(v[4][j], v[5][j], v[6][j], v[7][j]), pk4_fp8(v[8][j], v[9][j], v[10][j], v[11][j]), pk4_fp8(v[12][j], v[13][j], v[14][j], v[15][j])};
}
__device__ __forceinline__ void conv_wdown_item(const float* wd, unsigned char* WDF, int it, int lane) {
    const int e = it >> 8, kb = (it >> 4) & 15, nb = it & 15; conv_item_fp8(wd + (size_t)e * 1048576, WDF, 64 * kb, 64 * nb, e * 1024 + 64 * nb, lane); }
__device__ __forceinline__ void conv_gu_item(const float* wg, const float* wu, unsigned char* GUF, int it, int lane) {
    const int which = it >> 13, e = (it >> 8) & 31, kb = (it >> 4) & 15, nb = it & 15, n0 = 64 * nb;
    conv_item_fp8((which ? wu : wg) + (size_t)e * 1048576, GUF, 64 * kb, n0, e * 2048 + 256 * (n0 >> 7) + 128 * which + (n0 & 127), lane); }
__device__ __forceinline__ void rms_row_to_bf16(const float* xrow, const float* g, bf16* orow, int lane) {
    const GAS f32x4* xr = (const GAS f32x4*)xrow + lane; const GAS f32x4* gr = (const GAS f32x4*)g + lane;
    f32x4 v[4]; float s = 0.f;
#pragma unroll
    for (int j = 0; j < 4; ++j) { v[j] = xr[64 * j]; s += (v[j].x * v[j].x + v[j].y * v[j].y) + (v[j].z * v[j].z + v[j].w * v[j].w); }
    const float rstd = 1.f / sqrtf(wave_sum(s) * (1.f / D_MODEL) + NORM_EPS);
    GAS unsigned long long* o8 = (GAS unsigned long long*)orow + lane;
#pragma unroll
    for (int j = 0; j < 4; ++j) { const f32x4 gg = gr[64 * j];
        o8[64 * j] = (unsigned long long)pk2(v[j].x * rstd * gg.x, v[j].y * rstd * gg.y) | ((unsigned long long)pk2(v[j].z * rstd * gg.z, v[j].w * rstd * gg.w) << 32); }
}
__device__ __forceinline__ void p0_prologue(Frame& F, const float* x, const float* g_mix, const float* w_in, const float* w_out) {
    LAS float* scr = (LAS float*)(F.lds + RING_OFF + F.wave * 16384);
    const int gw = F.vcu * NWAVES + F.wave, NGW = F.G * NWAVES;
    bf16* WIN = (bf16*)(F.ws + WS_WIN); bf16* WOUT = (bf16*)(F.ws + WS_WOUT); bf16* XN = (bf16*)(F.ws + WS_BB);
    constexpr int I_IN = 16 * (INW / 32), I_OUT = 16 * 32;
    for (int it = gw; it < I_IN + I_OUT; it += NGW) {
        if (it < I_IN) { const int kb = it / (INW / 32), nb = it % (INW / 32); p0_transpose_item(w_in, INW, WIN, 1024, 64 * kb, 32 * nb, 32 * nb, scr, F.lane); }
        else { const int r = it - I_IN, kb = r / 32, nb = r % 32; p0_transpose_item(w_out, 1024, WOUT, 1024, 64 * kb, 32 * nb, 32 * nb, scr, F.lane); }
    }
    for (int i = gw * 64 + F.lane; i < (INW_PAD - INW) * 1024 / 8; i += NGW * 64) ((GAS v4u*)(WIN + (size_t)INW * 1024))[i] = (v4u){0u, 0u, 0u, 0u};
    {
        const GAS f32x4* gr = (const GAS f32x4*)g_mix + F.lane; f32x4 gg[4];
#pragma unroll
        for (int j = 0; j < 4; ++j) gg[j] = gr[64 * j];
        for (int m0 = gw; m0 < T_TOK; m0 += 4 * NGW) {
            f32x4 v[4][4]; float sq[4];
#pragma unroll
            for (int u = 0; u < 4; ++u)
#pragma unroll
                for (int j = 0; j < 4; ++j) v[u][j] = *((const GAS f32x4*)(x + (size_t)(m0 + u * NGW) * D_MODEL) + F.lane + 64 * j);
#pragma unroll
            for (int u = 0; u < 4; ++u) { float a = 0.f;
#pragma unroll
                for (int j = 0; j < 4; ++j) a += (v[u][j].x * v[u][j].x + v[u][j].y * v[u][j].y) + (v[u][j].z * v[u][j].z + v[u][j].w * v[u][j].w);
                sq[u] = a; }
#pragma unroll
            for (int u = 0; u < 4; ++u) { const float rstd = 1.f / sqrtf(wave_sum(sq[u]) * (1.f / D_MODEL) + NORM_EPS);
                GAS unsigned long long* o8 = (GAS unsigned long long*)(XN + (size_t)(m0 + u * NGW) * D_MODEL) + F.lane;
#pragma unroll
                for (int j = 0; j < 4; ++j) o8[64 * j] = (unsigned long long)pk2(v[u][j].x * rstd * gg[j].x, v[u][j].y * rstd * gg[j].y) | ((unsigned long long)pk2(v[u][j].z * rstd * gg[j].z, v[u][j].w * rstd * gg[j].w) << 32); }
        }
    }
}
__device__ __forceinline__ void p0_moe_weights(Frame& F, const float* wg, const float* wu, const float* wd) {
    LAS float* scr = (LAS float*)(F.lds + RING_OFF + F.wave * 16384);
    const int gw = F.vcu * NWAVES + F.wave, NGW = F.G * NWAVES;
    unsigned char* GU = F.ws + WS_GU; unsigned char* WD = F.ws + WS_WD;
    constexpr int IPE = 16 * 32;
    for (int it = gw; it < NEXP * 3 * IPE; it += NGW) {
        const int e = it / (3 * IPE), r = it % (3 * IPE), which = r / IPE, q = r % IPE, kb = q / 32, nb = q % 32, n0 = 32 * nb;
        if (which == 0) p0_transpose_item_fp8(wg + (size_t)e * 1048576, 1024, GU, 1024, 64 * kb, n0, e * 2048 + 256 * (n0 >> 7) + (n0 & 127), scr, F.lane);
        else if (which == 1) p0_transpose_item_fp8(wu + (size_t)e * 1048576, 1024, GU, 1024, 64 * kb, n0, e * 2048 + 256 * (n0 >> 7) + 128 + (n0 & 127), scr, F.lane);
        else p0_transpose_item_fp8(wd + (size_t)e * 1048576, 1024, WD, 1024, 64 * kb, n0, e * 1024 + n0, scr, F.lane);
    }
}

struct EpiProj {
    static constexpr bool PERM = true;
    bf16* O; int ldc;
    __device__ __forceinline__ void operator()(const f32x4 (&acc)[2][2][4][2], const pg8::Unit& u, int wr, int wc, int fr, int fq) const {
        const int row0 = u.orow0 + wr * 64 + fr, col0 = u.ocol0 + wc * 32 + 8 * fq;
#pragma unroll
        for (int ai = 0; ai < 2; ++ai)
#pragma unroll
            for (int m = 0; m < 4; ++m) { bf16* rowp = O + (size_t)(row0 + ai * 128 + m * 16) * ldc + col0;
#pragma unroll
                for (int bj = 0; bj < 2; ++bj) { const f32x4 v0 = acc[ai][bj][m][0], v1 = acc[ai][bj][m][1];
                    v4u w; w.x = pg8::cvt_pk_bf16(v0[0], v0[1]); w.y = pg8::cvt_pk_bf16(v0[2], v0[3]); w.z = pg8::cvt_pk_bf16(v1[0], v1[1]); w.w = pg8::cvt_pk_bf16(v1[2], v1[3]);
                    *(v4u*)(rowp + bj * 128) = w; } }
    }
};
struct EpiResid {
    static constexpr bool PERM = true;
    const float* base; bf16* out;
    __device__ __forceinline__ void operator()(const f32x4 (&acc)[2][2][4][2], const pg8::Unit& u, int wr, int wc, int fr, int fq) const {
        const int row0 = u.orow0 + wr * 64 + fr, col0 = u.ocol0 + wc * 32 + 8 * fq;
#pragma unroll
        for (int ai = 0; ai < 2; ++ai)
#pragma unroll
            for (int m = 0; m < 4; ++m) { const size_t off = (size_t)(row0 + ai * 128 + m * 16) * D_MODEL + col0;
#pragma unroll
                for (int bj = 0; bj < 2; ++bj) { const f32x4 v0 = *(const f32x4*)(base + off + bj * 128) + acc[ai][bj][m][0], v1 = *(const f32x4*)(base + off + bj * 128 + 4) + acc[ai][bj][m][1];
                    v4u w; w.x = pg8::cvt_pk_bf16(v0[0], v0[1]); w.y = pg8::cvt_pk_bf16(v0[2], v0[3]); w.z = pg8::cvt_pk_bf16(v1[0], v1[1]); w.w = pg8::cvt_pk_bf16(v1[2], v1[3]);
                    *(v4u*)(out + off + bj * 128) = w; }
                asm volatile("" ::: "memory"); }
    }
};
struct EpiGlu {
    static constexpr bool PERM = true;
    unsigned char* H; const LAS unsigned short* btab;
    __device__ __forceinline__ void operator()(const f32x4 (&acc)[2][2][4][2], const pg8::Unit& u, int wr, int wc, int fr, int fq) const {
        const int lrow0 = wr * 64 + fr, cl = wc * 32 + 8 * fq, col0 = u.ocol0 + cl;
        const v4u gw = *(const LAS v4u*)(btab + u.idx * 256 + cl), uw = *(const LAS v4u*)(btab + u.idx * 256 + 128 + cl);
        const f32x4 gb0 = {bflo(gw.x), bfhi(gw.x), bflo(gw.y), bfhi(gw.y)}, gb1 = {bflo(gw.z), bfhi(gw.z), bflo(gw.w), bfhi(gw.w)};
        const f32x4 ub0 = {bflo(uw.x), bfhi(uw.x), bflo(uw.y), bfhi(uw.y)}, ub1 = {bflo(uw.z), bfhi(uw.z), bflo(uw.w), bfhi(uw.w)};
#pragma unroll
        for (int ai = 0; ai < 2; ++ai)
#pragma unroll
            for (int m = 0; m < 4; ++m) { const int lr = lrow0 + ai * 128 + m * 16; unsigned w[2];
#pragma unroll
                for (int n = 0; n < 2; ++n) { const f32x4 gv = acc[ai][0][m][n] * WSCALE_INV + (n ? gb1 : gb0), uv = acc[ai][1][m][n] * WSCALE_INV + (n ? ub1 : ub0); float hv[4];
#pragma unroll
                    for (int j = 0; j < 4; ++j) { const float ga = fminf(gv[j], 7.0f), up = fminf(fmaxf(uv[j], -7.0f), 7.0f);
                        const float glu = ga * __builtin_amdgcn_rcpf(1.0f + __builtin_amdgcn_exp2f(-1.702f * 1.4426950408889634f * ga)); hv[j] = (up + 1.0f) * glu; }
                    w[n] = pk4_fp8(hv[0], hv[1], hv[2], hv[3]); }
                if (lr < u.cnt) *(v2u*)(H + (size_t)(u.orow0 + lr) * 1024 + col0) = (v2u){w[0], w[1]};
                asm volatile("" ::: "memory"); }
    }
};
struct EpiDown {
    static constexpr bool PERM = true;
    unsigned char* Y1; const float* bd; const LAS float* gtab;
    __device__ __forceinline__ void operator()(const f32x4 (&acc)[2][2][4][2], const pg8::Unit& u, int wr, int wc, int fr, int fq) const {
        const int lrow0 = wr * 64 + fr, col0 = u.ocol0 + wc * 32 + 8 * fq;
        const float* bp = bd + (size_t)u.e * 1024 + col0;
#pragma unroll
        for (int bj = 0; bj < 2; ++bj) {
            const f32x4 b0 = *(const f32x4*)(bp + bj * 128), b1 = *(const f32x4*)(bp + bj * 128 + 4);
#pragma unroll
            for (int ai = 0; ai < 2; ++ai)
#pragma unroll
                for (int m = 0; m < 4; ++m) { const int lr = lrow0 + ai * 128 + m * 16; const int slot = u.orow0 + lr;
                    if (lr < u.cnt) { const float gt = gtab[u.idx * 256 + lr] * YSCALE;
                        const f32x4 v0 = (acc[ai][bj][m][0] * WSCALE_INV + b0) * gt, v1 = (acc[ai][bj][m][1] * WSCALE_INV + b1) * gt;
                        *(v2u*)(Y1 + (size_t)slot * 1024 + col0 + bj * 128) = (v2u){pk4_fp8(v0[0], v0[1], v0[2], v0[3]), pk4_fp8(v1[0], v1[1], v1[2], v1[3])}; } }
            asm volatile("" ::: "memory"); }
    }
};
struct MoeOrder {
    const int* tiles; int t_lo, t_hi, NN, G, c; const int* slot_tok; int bstride;
    __device__ __forceinline__ bool next(int i, pg8::Unit& u) const {
        const int nM = t_hi - t_lo, nN = NN, nwg = nM * nN;
        const long L = (long)i * G + c; if (L >= nwg) return false;
        int wgid = (int)L; { const int q = nwg / 8, r = nwg % 8, xcd = wgid % 8, off = wgid / 8; wgid = (xcd < r ? xcd * (q + 1) : r * (q + 1) + (xcd - r) * q) + off; }
        const int nig = 8 * nN, gid = wgid / nig, fm = gid * 8, gsz = (nM - fm) < 8 ? (nM - fm) : 8;
        const int pm = t_lo + fm + ((wgid % nig) % gsz), pn = (wgid % nig) / gsz;
        const int e = __builtin_amdgcn_readfirstlane(tiles[4 * pm]), row0 = __builtin_amdgcn_readfirstlane(tiles[4 * pm + 1]), cnt = __builtin_amdgcn_readfirstlane(tiles[4 * pm + 2]);
        u.e = e; u.arow0 = row0; u.orow0 = row0; u.cnt = cnt; u.rows = slot_tok + row0; u.idx = i; u.brow0 = e * bstride + pn * 256; u.ocol0 = (NN == 8) ? pn * 128 : pn * 256; return true;
    }
};
__device__ __forceinline__ void p2_qkstats(Frame& F, unsigned* qkn) {
    const bf16* PROJ = (const bf16*)(F.ws + WS_PROJ); float* KM = (float*)(F.ws + WS_TAB + TAB_KMEAN);
    const int gw = F.vcu * NWAVES + F.wave, NGW = F.G * NWAVES;
    for (int u2 = gw; u2 < BATCH * 16 * NH * 2; u2 += NGW) {
        const int which = u2 & 1, u = u2 >> 1, h = u & 7, bb = u >> 3, b = bb >> 4, blk = bb & 15; const int ch = F.lane & 7, ts = F.lane >> 3;
        const bf16* kp = PROJ + ((size_t)b * SEQ + blk * 256 + ts) * INW_PAD + (which ? 0 : ATTN_W) + h * 64 + ch * 8;
        float s[8]; float mx = 0.f;
#pragma unroll
        for (int j = 0; j < 8; ++j) s[j] = 0.f;
#pragma unroll 8
        for (int i = 0; i < 32; ++i) { const v4u w = *(const v4u*)(kp + (size_t)(8 * i) * INW_PAD);
            const float a0 = bflo(w.x), a1 = bfhi(w.x), a2 = bflo(w.y), a3 = bfhi(w.y), a4 = bflo(w.z), a5 = bfhi(w.z), a6 = bflo(w.w), a7 = bfhi(w.w);
            s[0] += a0; s[1] += a1; s[2] += a2; s[3] += a3; s[4] += a4; s[5] += a5; s[6] += a6; s[7] += a7;
            float n2 = (a0 * a0 + a1 * a1) + (a2 * a2 + a3 * a3) + (a4 * a4 + a5 * a5) + (a6 * a6 + a7 * a7);
            n2 += __shfl_xor(n2, 1); n2 += __shfl_xor(n2, 2); n2 += __shfl_xor(n2, 4);
            mx = fmaxf(mx, n2); }
        mx = fmaxf(mx, __shfl_xor(mx, 8)); mx = fmaxf(mx, __shfl_xor(mx, 16)); mx = fmaxf(mx, __shfl_xor(mx, 32));
        if (F.lane == 0) atomicMax(qkn + (b * NH + h) * 2 + (which ? 0 : 1), __float_as_uint(mx));
        if (!which) {
#pragma unroll
            for (int j = 0; j < 8; ++j) { s[j] += __shfl_xor(s[j], 8); s[j] += __shfl_xor(s[j], 16); s[j] += __shfl_xor(s[j], 32); }
            if (ts == 0) { float* o = KM + (((size_t)b * NH + h) * 16 + blk) * 64 + ch * 8;
                *(f32x4*)o = (f32x4){s[0], s[1], s[2], s[3]} * (1.f / 256.f); *(f32x4*)(o + 4) = (f32x4){s[4], s[5], s[6], s[7]} * (1.f / 256.f); } }
    }
}

struct RwkvPrepOut { bf16 *R, *W, *K, *V, *KK, *BV, *G; float* bonus; };
__device__ __forceinline__ void p2_rwkv_prep(Frame& F, const float* mu, const float* w0, const float* w2, const float* a0, const float* a2, const float* g2,
                                             const float* k_k, const float* k_a, const float* r_k, const RwkvPrepOut& O) {
    const bf16* PROJ = (const bf16*)(F.ws + WS_PROJ);
    const int c = F.tid;
    float cw2[32], ca2[32], cg2[96];
#pragma unroll
    for (int j = 0; j < 32; ++j) { cw2[j] = w2[j * 512 + c]; ca2[j] = a2[j * 512 + c]; }
#pragma unroll
    for (int j = 0; j < 96; ++j) cg2[j] = g2[j * 512 + c];
    const float mu_r = mu[c], mu_k = mu[512 + c], mu_v = mu[1024 + c], mu_d = (c < 160) ? mu[1536 + c] : 0.f;
    const float w0c = w0[c], a0c = a0[c], kkc = k_k[c], kac = k_a[c], rkc = r_k[c];
    LAS float* lin = (LAS float*)(F.lds + RING_OFF);
    constexpr int TB = 16;
    const int ntb = T_TOK / TB;
    for (int tb = F.vcu; tb < ntb; tb += F.G) {
        const int t0 = tb * TB;
        __syncthreads();
        if (c < 160) {
#pragma unroll 4
            for (int i = 0; i < TB; ++i) { const int t = t0 + i; const bool first = (t % SEQ) == 0;
                const float xc = bf2f(PROJ[(size_t)t * INW_PAD + XR_OFF + 1536 + c]);
                const float xp = first ? 0.f : bf2f(PROJ[(size_t)(t - 1) * INW_PAD + XR_OFF + 1536 + c]);
                const float xs = xc + (xp - xc) * mu_d;
                float f; if (c < 32) f = tanhf(xs); else if (c < 64) f = xs; else f = sigmoidf_(xs);
                lin[i * 160 + c] = f; }
        }
        __syncthreads();
        for (int i = 0; i < TB; ++i) { const int t = t0 + i; const bool first = (t % SEQ) == 0;
            const bf16* pc = PROJ + (size_t)t * INW_PAD + XR_OFF; const bf16* pp = pc - INW_PAD;
            const float rc_ = bf2f(pc[c]), kc_ = bf2f(pc[512 + c]), vc_ = bf2f(pc[1024 + c]);
            const float rp_ = first ? 0.f : bf2f(pp[c]), kp_ = first ? 0.f : bf2f(pp[512 + c]), vp_ = first ? 0.f : bf2f(pp[1024 + c]);
            const float r = rc_ + (rp_ - rc_) * mu_r, k = kc_ + (kp_ - kc_) * mu_k, v = vc_ + (vp_ - vc_) * mu_v;
            float wp = w0c, ap = a0c, g = 0.f;
            const LAS float* li = lin + i * 160;
#pragma unroll
            for (int j = 0; j < 32; ++j) { wp += li[j] * cw2[j]; ap += li[32 + j] * ca2[j]; }
#pragma unroll
            for (int j = 0; j < 96; ++j) g += li[64 + j] * cg2[j];
            const float w = __expf(-DECAY_SCALE * sigmoidf_(wp)), a = sigmoidf_(ap);
            float kk = k * kkc; const float ss = wave_sum(kk * kk); kk = kk * (1.0f / sqrtf(fmaxf(ss, 1e-24f)));
            const float k2 = k * (1.0f + (a - 1.0f) * kac), bv = kk * a;
            const float bon = wave_sum(r * k2 * rkc);
            const size_t o = (size_t)t * 512 + c;
            O.R[o] = (bf16)f2bf(r); O.W[o] = (bf16)f2bf(w); O.K[o] = (bf16)f2bf(k2); O.V[o] = (bf16)f2bf(v); O.KK[o] = (bf16)f2bf(kk); O.BV[o] = (bf16)f2bf(bv); O.G[o] = (bf16)f2bf(g);
            if (F.lane == 0) O.bonus[(size_t)t * 8 + F.wave] = bon;
        }
    }
}
namespace att {
using bf16x8 = __attribute__((ext_vector_type(8))) short;
using s16x4 = __attribute__((ext_vector_type(4))) short;
using f32x16 = __attribute__((ext_vector_type(16))) float;
using u32x4 = __attribute__((ext_vector_type(4))) unsigned;
constexpr int D = 64, DM = INW_PAD, OP = INW_PAD;
constexpr int NW = 8, QBLK = 32, QB = QBLK * NW, KVBLK = 64, NQB = SEQ / QB;
constexpr float C2 = 0.125f * 1.4426950408889634f;
constexpr float THR = 8.0f;
constexpr int SLOTB = 8192, LDS_K = 0, LDS_V = 3 * SLOTB, LDS_WS = 6 * SLOTB, LDS_OST = LDS_WS + NW * 256, LDS_BYTES = LDS_OST + NW * 8192;
#define SBAR() __builtin_amdgcn_sched_barrier(0)
#define PIN(x) asm volatile("" : "+v"(x))
#define MFMA(a, b, c) __builtin_amdgcn_mfma_f32_32x32x16_bf16(a, b, c, 0, 0, 0)
#define WAIT_BAR(N) asm volatile("s_waitcnt vmcnt(" #N ") lgkmcnt(0)\n\ts_barrier" ::: "memory")
__device__ __forceinline__ int crow(int r, int hi) { return (r & 3) + 8 * (r >> 2) + 4 * hi; }
__device__ __forceinline__ unsigned cvtpk(float lo, float hi) { unsigned r; asm("v_cvt_pk_bf16_f32 %0, %1, %2" : "=v"(r) : "v"(lo), "v"(hi)); return r; }
__device__ __forceinline__ void glds16(const void* g, unsigned lds_base) {
    unsigned sv; asm volatile("s_mov_b32 %0, m0\n\ts_mov_b32 m0, %2\n\ts_nop 0\n\tglobal_load_lds_dwordx4 %1, off\n\ts_mov_b32 m0, %0" : "=&s"(sv) : "v"(g), "s"(lds_base) : "memory"); }
typedef __attribute__((address_space(3))) const char* lds_cptr;
typedef short v4i16_t __attribute__((ext_vector_type(4)));
__device__ __forceinline__ void kload2(bf16x8* kf, lds_cptr kp, int d0) { kf[2 * d0] = *(const __attribute__((address_space(3))) bf16x8*)(kp + d0 * 2048); kf[2 * d0 + 1] = *(const __attribute__((address_space(3))) bf16x8*)(kp + d0 * 2048 + 512); }
__device__ __forceinline__ s16x4 vtr(lds_cptr p) { return __builtin_bit_cast(s16x4, __builtin_amdgcn_ds_read_tr16_b64_v4i16((__attribute__((address_space(3))) v4i16_t*)p)); }
#define MX3(a, b, c) __builtin_fmaxf(__builtin_fmaxf((a), (b)), (c))
__device__ __forceinline__ float max16(const f32x16& p) {
    float a = MX3(p[0], p[1], p[2]), b = MX3(p[3], p[4], p[5]); a = MX3(a, p[6], p[7]); b = MX3(b, p[8], p[9]); a = MX3(a, p[10], p[11]); b = MX3(b, p[12], p[13]); a = MX3(a, p[14], p[15]);
    return __builtin_fmaxf(a, b); }
__device__ __forceinline__ float rowmax(const f32x16& p0, const f32x16& p1, float b32) {
    const float m = __builtin_fmaxf(max16(p0), max16(p1) + b32); auto rr = __builtin_amdgcn_permlane32_swap(__float_as_uint(m), __float_as_uint(m), false, false);
    return __builtin_fmaxf(__uint_as_float(rr[0]), __uint_as_float(rr[1])); }
__device__ __forceinline__ void cmask(f32x16& p0, f32x16& p1, int jb, int qrel, int hi) {
    const int kb = 64 * jb + 4 * hi;
#pragma unroll
    for (int r = 0; r < 16; ++r) { const int kv = kb + (r & 3) + 8 * (r >> 2); if (kv > qrel) p0[r] = -INFINITY; if (kv + 32 > qrel) p1[r] = -INFINITY; } }

__device__ __forceinline__ void attn_unit(int b, int h, int qb, const bf16* P, const float* KM, const unsigned* qkn, const float* gnorm, bf16* O, char* lds) {
    asm volatile("" : "+s"(b), "+s"(h), "+s"(qb));
    int tid = threadIdx.x; asm volatile("" : "+v"(tid));
    const int lane = tid & 63, r32 = lane & 31, hi = lane >> 5; const int wid = __builtin_amdgcn_readfirstlane(tid >> 6);
    const long rowbase = (long)b * SEQ; const int q0 = qb * QB;
    int t_start;
    { const float beta_ = __builtin_amdgcn_exp2f(-(float)(h + 1)) * 1.4426950408889634f;
      const float qm = sqrtf(__uint_as_float(__builtin_amdgcn_readfirstlane(qkn[(b * NH + h) * 2]))), km = sqrtf(__uint_as_float(__builtin_amdgcn_readfirstlane(qkn[(b * NH + h) * 2 + 1])));
      const float dk = (40.0f + 2.0f * C2 * qm * km) / beta_;
      const float ts = floorf(((float)(q0 + 1) - dk) * (1.0f / 64.0f));
      t_start = (ts > 0.f) ? ((int)ts & ~1) : 0; t_start = __builtin_amdgcn_readfirstlane(t_start); }
    const int NT = (q0 + QB) / KVBLK - t_start;
    const bf16* Qw = P + (rowbase + q0 + wid * QBLK) * DM + h * D;
    const bf16* K = P + ATTN_W; const bf16* V = P + 2 * ATTN_W;
    const unsigned lds0 = (unsigned)(uintptr_t)lds; float* wsf = (float*)(lds + LDS_WS) + wid * 64;
    const bf16* ksrc = K + (rowbase + (long)t_start * KVBLK) * DM + h * D + (long)lane * DM + wid * 8;
    const bf16* vsrc = V + (rowbase + (long)t_start * KVBLK) * DM + h * D + (long)(16 * (wid & 3) + (lane >> 2)) * DM + (wid >> 2) * 32 + (lane & 3) * 8;
    const unsigned kdst = lds0 + LDS_K + wid * 1024, vdst = lds0 + LDS_V + wid * 1024;
#define DMA_K(t, slot) glds16(ksrc + (long)(t) * KVBLK * DM, (unsigned)__builtin_amdgcn_readfirstlane(kdst + (slot)))
#define DMA_V(t, slot) glds16(vsrc + (long)(t) * KVBLK * DM, (unsigned)__builtin_amdgcn_readfirstlane(vdst + (slot)))
    const lds_cptr vp0 = (lds_cptr)lds + LDS_V + ((lane >> 4) & 1) * 32 + (lane & 3) * 8 + (4 * hi + ((lane & 15) >> 2)) * 64;
    const lds_cptr kp0 = (lds_cptr)lds + LDS_K + hi * 1024 + r32 * 16;
    DMA_K(0, 0); DMA_V(0, 0); DMA_K(1, SLOTB);
    bf16x8 qr[4];
#pragma unroll
    for (int d0 = 0; d0 < 4; ++d0) qr[d0] = *reinterpret_cast<const bf16x8*>(&Qw[(long)r32 * DM + d0 * 16 + hi * 8]);
    unsigned selmask = 0u;
    {
        f32x16 ga = f32x16{};
        int tg = threadIdx.x; asm volatile("" : "+v"(tg)); const int r32g = tg & 31, hig = (tg >> 5) & 1;
        const float* kmp = KM + (((size_t)b * NH + h) * 16 + (r32g & 15)) * 64 + hig * 8;
#pragma unroll
        for (int d0 = 0; d0 < 4; ++d0) {
            const f32x4 x0 = *(const f32x4*)(kmp + d0 * 16), x1 = *(const f32x4*)(kmp + d0 * 16 + 4);
            float xv[8] = {x0[0], x0[1], x0[2], x0[3], x1[0], x1[1], x1[2], x1[3]}; unsigned wh[4], wl[4];
#pragma unroll
            for (int j = 0; j < 4; ++j) { const float a0 = (r32g < 16) ? xv[2 * j] : 0.f, a1 = (r32g < 16) ? xv[2 * j + 1] : 0.f; wh[j] = cvtpk(a0, a1);
                const float l0 = a0 - bflo(wh[j]), l1 = a1 - bfhi(wh[j]); wl[j] = cvtpk(l0, l1); }
            const bf16x8 fh = __builtin_bit_cast(bf16x8, (u32x4){wh[0], wh[1], wh[2], wh[3]}), fl = __builtin_bit_cast(bf16x8, (u32x4){wl[0], wl[1], wl[2], wl[3]});
            ga = MFMA(fh, qr[d0], ga); ga = MFMA(fl, qr[d0], ga);
        }
        float g[16];
#pragma unroll
        for (int r = 0; r < 8; ++r) { auto rr = __builtin_amdgcn_permlane32_swap(__float_as_uint(ga[r]), __float_as_uint(ga[r]), false, false);
            const int blk = (r & 3) + 8 * (r >> 2); g[blk] = __uint_as_float(rr[0]); g[blk + 4] = __uint_as_float(rr[1]); }
#pragma unroll
        for (int rnd = 0; rnd < 3; ++rnd) { float best = -3e38f; int bi = -1;
#pragma unroll
            for (int j = 0; j < 16; ++j) { const bool ok = (j < qb) && !((selmask >> j) & 1u) && (g[j] > best); best = ok ? g[j] : best; bi = ok ? j : bi; }
            selmask |= (bi >= 0) ? (1u << bi) : 0u; }
    }
    const float slope = __builtin_amdgcn_exp2f(-(float)(h + 1)), beta = slope * 1.4426950408889634f, b32 = 32.0f * beta / C2, beta32 = 32.0f * beta;
    f32x16 bias16;
#pragma unroll
    for (int r = 0; r < 16; ++r) bias16[r] = (beta / C2) * (float)crow(r, hi);
    PIN(bias16);
    float mhat = -1e30f, l_reg = 0.f; f32x16 o[2]; o[0] = f32x16{}; o[1] = f32x16{};
    const int qrel = wid * QBLK + r32; bool resc = false;
    f32x16 pA0, pA1, pB0, pB1; bf16x8 kf[8]; s16x4 vlo[8], vhi[8]; u32x4 pw0, pw1, pw2, pw3;
    int sl_prev = 0, sl_cur = 0, sl_next = SLOTB;
#define ROT() do { sl_prev = sl_cur; sl_cur = sl_next; sl_next = (sl_next == 2 * SLOTB) ? 0 : sl_next + SLOTB; } while (0)
#define EX0(v) __builtin_amdgcn_exp2f(__builtin_fmaf((v), C2, nmh0))
#define EX1(v) __builtin_amdgcn_exp2f(__builtin_fmaf((v), C2, nmh1))
#define RESC() do { if (resc) { _Pragma("unroll") for (int d_ = 0; d_ < 2; ++d_) _Pragma("unroll") for (int r = 0; r < 16; ++r) o[d_][r] *= wsf[crow(r, hi)]; } } while (0)
#define DECIDE(C0, C1, tt) \
      const bool lsel_ = ((tt) >= NT - 4) || (((selmask >> (((tt) + t_start) >> 2)) & 1u) != 0u); \
      const float bs0_ = beta * (float)(((tt) + t_start) * KVBLK); \
      float rmabs_ = __builtin_fmaf(rowmax(C0, C1, b32), C2, bs0_); rmabs_ = lsel_ ? rmabs_ : -1e30f; resc = false; \
      if (__any((rmabs_ - mhat) > THR)) { const float mnew_ = __builtin_fmaxf(mhat, rmabs_); const float f_ = __builtin_amdgcn_exp2f(mhat - mnew_); mhat = mnew_; l_reg *= f_; if (hi == 0) wsf[r32] = f_; resc = true; } \
      const float nmh0 = lsel_ ? (bs0_ - mhat) : -INFINITY; const float nmh1 = nmh0 + beta32;
    DMA_K(2, 2 * SLOTB);
    WAIT_BAR(3);
    _Pragma("unroll") for (int d0 = 0; d0 < 4; ++d0) kload2(kf, kp0, d0);
    pA0 = MFMA(kf[0], qr[0], bias16); pA1 = MFMA(kf[1], qr[0], bias16); pA0 = MFMA(kf[2], qr[1], pA0); pA1 = MFMA(kf[3], qr[1], pA1);
    pA0 = MFMA(kf[4], qr[2], pA0); pA1 = MFMA(kf[5], qr[2], pA1); pA0 = MFMA(kf[6], qr[3], pA0); pA1 = MFMA(kf[7], qr[3], pA1);
    if (NT == 4) cmask(pA0, pA1, 0, qrel, hi);
    { DECIDE(pA0, pA1, 0)
#pragma unroll
      for (int r = 0; r < 16; ++r) { pA0[r] = EX0(pA0[r]); pA1[r] = EX1(pA1[r]); } }
    WAIT_BAR(0);
    RESC();
    DMA_K(3, 0); DMA_V(1, SLOTB); ROT();
    _Pragma("unroll") for (int d0 = 0; d0 < 4; ++d0) kload2(kf, kp0 + sl_cur, d0);
    WAIT_BAR(2);
#define PKW(P_, i) cvtpk(P_[i], P_[i + 1])
#define PAF(k) __builtin_bit_cast(bf16x8, pw##k)
#define VFR(i) (bf16x8){vlo[i][0], vlo[i][1], vlo[i][2], vlo[i][3], vhi[i][0], vhi[i][1], vhi[i][2], vhi[i][3]}
#define VRD(i) do { vlo[i] = vtr(vp_ + (((i) >> 2) * 4096 + ((i) & 3) * 1024)); vhi[i] = vtr(vp_ + (((i) >> 2) * 4096 + ((i) & 3) * 1024 + 512)); } while (0)
#define KRD(G, d0) do { if (G) { kload2(kf, kp0 + sl_next, d0); SBAR(); } } while (0)
#define GAPA(MF, a0, a1, a2, a3, W0, W1, PW) do { MF; sacc += a0; sacc += a1; sacc += a2; sacc += a3; W0; W1; PIN(PW); PIN(sacc); SBAR(); } while (0)
#define GAPB0(MF, X, i) do { MF; X[i] = EX0(X[i]); X[i + 1] = EX0(X[i + 1]); X[i + 2] = EX0(X[i + 2]); X[i + 3] = EX0(X[i + 3]); PIN(X); SBAR(); } while (0)
#define GAPB1(MF, X, i) do { MF; X[i] = EX1(X[i]); X[i + 1] = EX1(X[i + 1]); X[i + 2] = EX1(X[i + 2]); X[i + 3] = EX1(X[i + 3]); PIN(X); SBAR(); } while (0)
#define STEP(C0, C1, P0, P1, t, MASK, GK, GV, GL) do { SBAR(); \
    const lds_cptr vp_ = vp0 + sl_prev; \
    VRD(0); SBAR(); float sacc = P0[0] + P0[1]; \
                    GAPA(C0 = MFMA(kf[0], qr[0], bias16), P0[2], P0[3], P0[4], P0[5],     pw0[0] = PKW(P0, 0),  pw0[1] = PKW(P0, 2),  pw0); \
    VRD(4); SBAR(); GAPA(C1 = MFMA(kf[1], qr[0], bias16), P0[6], P0[7], P0[8], P0[9],     pw0[2] = PKW(P0, 4),  pw0[3] = PKW(P0, 6),  pw0); \
    VRD(1); SBAR(); GAPA(C0 = MFMA(kf[2], qr[1], C0),    P0[10], P0[11], P0[12], P0[13], pw1[0] = PKW(P0, 8),  pw1[1] = PKW(P0, 10), pw1); \
    VRD(5); SBAR(); GAPA(C1 = MFMA(kf[3], qr[1], C1),    P0[14], P0[15], P1[0], P1[1],   pw1[2] = PKW(P0, 12), pw1[3] = PKW(P0, 14), pw1); \
    VRD(2); SBAR(); GAPA(C0 = MFMA(kf[4], qr[2], C0),    P1[2], P1[3], P1[4], P1[5],     pw2[0] = PKW(P1, 0),  pw2[1] = PKW(P1, 2),  pw2); \
    VRD(6); SBAR(); GAPA(C1 = MFMA(kf[5], qr[2], C1),    P1[6], P1[7], P1[8], P1[9],     pw2[2] = PKW(P1, 4),  pw2[3] = PKW(P1, 6),  pw2); \
    VRD(3); SBAR(); GAPA(C0 = MFMA(kf[6], qr[3], C0),    P1[10], P1[11], P1[12], P1[13], pw3[0] = PKW(P1, 8),  pw3[1] = PKW(P1, 10), pw3); \
    VRD(7); SBAR(); GAPA(C1 = MFMA(kf[7], qr[3], C1),    P1[14], P1[15], 0.f, 0.f,       pw3[2] = PKW(P1, 12), pw3[3] = PKW(P1, 14), pw3); \
    l_reg += sacc; \
    if (GK) DMA_K((t) + 3, sl_cur); if (GV) DMA_V((t) + 1, sl_next); \
    if (MASK) cmask(C0, C1, (t) - (NT - 4), qrel, hi); \
    DECIDE(C0, C1, t) \
    SBAR(); \
    GAPB0(o[0] = MFMA(PAF(0), VFR(0), o[0]), C0, 0);              GAPB0(o[1] = MFMA(PAF(0), VFR(4), o[1]), C0, 4); \
    KRD(GL, 0); GAPB0(o[0] = MFMA(PAF(1), VFR(1), o[0]), C0, 8);  KRD(GL, 1); GAPB0(o[1] = MFMA(PAF(1), VFR(5), o[1]), C0, 12); \
    KRD(GL, 2); GAPB1(o[0] = MFMA(PAF(2), VFR(2), o[0]), C1, 0);  KRD(GL, 3); GAPB1(o[1] = MFMA(PAF(2), VFR(6), o[1]), C1, 4); \
    GAPB1(o[0] = MFMA(PAF(3), VFR(3), o[0]), C1, 8);              GAPB1(o[1] = MFMA(PAF(3), VFR(7), o[1]), C1, 12); \
    } while (0)
    int t = 1;
    for (; t + 5 < NT; t += 2) {
        STEP(pB0, pB1, pA0, pA1, t, false, true, true, true);     WAIT_BAR(2); RESC(); ROT();
        STEP(pA0, pA1, pB0, pB1, t + 1, false, true, true, true); WAIT_BAR(2); RESC(); ROT();
    }
#define ENDW(tt) do { if ((tt) + 3 < NT) { WAIT_BAR(2); } else if ((tt) + 2 < NT) { WAIT_BAR(1); } else { WAIT_BAR(0); } } while (0)
    for (; t + 1 < NT; t += 2) {
        STEP(pB0, pB1, pA0, pA1, t, true, (t + 3 < NT), (t + 1 < NT), (t + 1 < NT));         ENDW(t);     RESC(); ROT();
        STEP(pA0, pA1, pB0, pB1, t + 1, true, (t + 4 < NT), (t + 2 < NT), (t + 2 < NT));     ENDW(t + 1); RESC(); ROT();
    }
    STEP(pB0, pB1, pA0, pA1, NT - 1, true, false, false, false); asm volatile("s_waitcnt lgkmcnt(0)" ::: "memory"); RESC();
    { float sacc = pB0[0] + pB0[1];
#pragma unroll
      for (int r = 2; r < 16; ++r) sacc += pB0[r];
#pragma unroll
      for (int r = 0; r < 16; ++r) sacc += pB1[r];
      l_reg += sacc;
      pw0 = (u32x4){PKW(pB0, 0), PKW(pB0, 2), PKW(pB0, 4), PKW(pB0, 6)}; pw1 = (u32x4){PKW(pB0, 8), PKW(pB0, 10), PKW(pB0, 12), PKW(pB0, 14)};
      pw2 = (u32x4){PKW(pB1, 0), PKW(pB1, 2), PKW(pB1, 4), PKW(pB1, 6)}; pw3 = (u32x4){PKW(pB1, 8), PKW(pB1, 10), PKW(pB1, 12), PKW(pB1, 14)};
      const lds_cptr vp_ = vp0 + sl_cur; _Pragma("unroll") for (int i = 0; i < 8; ++i) VRD(i);
      o[0] = MFMA(PAF(0), VFR(0), o[0]); o[1] = MFMA(PAF(0), VFR(4), o[1]); o[0] = MFMA(PAF(1), VFR(1), o[0]); o[1] = MFMA(PAF(1), VFR(5), o[1]);
      o[0] = MFMA(PAF(2), VFR(2), o[0]); o[1] = MFMA(PAF(2), VFR(6), o[1]); o[0] = MFMA(PAF(3), VFR(3), o[0]); o[1] = MFMA(PAF(3), VFR(7), o[1]); }
    { auto rr = __builtin_amdgcn_permlane32_swap(__float_as_uint(l_reg), __float_as_uint(l_reg), false, false); l_reg = __uint_as_float(rr[0]) + __uint_as_float(rr[1]); }
    int te = threadIdx.x; asm volatile("" : "+v"(te));
    const int lane_e = te & 63, r32e = lane_e & 31, hie = lane_e >> 5; const int wide = __builtin_amdgcn_readfirstlane(te >> 6);
    float* wsfe = (float*)(lds + LDS_WS) + wide * 64;
    if (hie == 0) wsfe[32 + r32e] = l_reg; asm volatile("s_waitcnt lgkmcnt(0)" ::: "memory");
    bf16* Ow = O + (rowbase + q0 + wide * QBLK) * OP + h * D; float* stg = (float*)(lds + LDS_OST) + wide * 2048;
#pragma unroll
    for (int r = 0; r < 16; ++r) { const int orow = crow(r, hie); const float rl = __builtin_amdgcn_rcpf(wsfe[32 + orow]);
#pragma unroll
        for (int d0 = 0; d0 < 2; ++d0) stg[orow * 64 + d0 * 32 + r32e] = o[d0][r] * rl; }
    asm volatile("s_waitcnt lgkmcnt(0)" ::: "memory");
#pragma unroll
    for (int i = 0; i < 4; ++i) { const int row = i * 8 + (lane_e >> 3), ch = lane_e & 7;
        const f32x4 a = *(const f32x4*)(stg + row * 64 + ch * 8), c = *(const f32x4*)(stg + row * 64 + ch * 8 + 4);
        float ss = (a[0] * a[0] + a[1] * a[1]) + (a[2] * a[2] + a[3] * a[3]) + (c[0] * c[0] + c[1] * c[1]) + (c[2] * c[2] + c[3] * c[3]);
        ss += __shfl_xor(ss, 1); ss += __shfl_xor(ss, 2); ss += __shfl_xor(ss, 4);
        const float rn = 1.0f / sqrtf(ss * (1.f / 64.f) + NORM_EPS);
        const f32x4 g0 = *(const f32x4*)(gnorm + h * 64 + ch * 8), g1 = *(const f32x4*)(gnorm + h * 64 + ch * 8 + 4);
        u32x4 w; w.x = cvtpk(a[0] * rn * g0[0], a[1] * rn * g0[1]); w.y = cvtpk(a[2] * rn * g0[2], a[3] * rn * g0[3]); w.z = cvtpk(c[0] * rn * g1[0], c[1] * rn * g1[1]); w.w = cvtpk(c[2] * rn * g1[2], c[3] * rn * g1[3]);
        *(u32x4*)(Ow + (long)row * OP + ch * 8) = w; asm volatile("" ::: "memory"); }
    asm volatile("s_waitcnt lgkmcnt(0)\n\ts_barrier" ::: "memory");
#undef DMA_K
#undef DMA_V
#undef ROT
#undef EX0
#undef EX1
#undef RESC
#undef DECIDE
#undef PKW
#undef PAF
#undef VFR
#undef VRD
#undef KRD
#undef ENDW
#undef GAPA
#undef GAPB0
#undef GAPB1
#undef STEP
}
#undef SBAR
#undef PIN
#undef MFMA
#undef WAIT_BAR
#undef MX3
__device__ __forceinline__ int attn_phase(unsigned* qh, volatile __attribute__((address_space(3))) unsigned* bc, const bf16* P, const float* KM, const unsigned* qkn, const float* gnorm, bf16* O, char* lds, int max_units) {
    const int grp = blockIdx.x & 7; int k = 0;
    for (int done_ = 0;; ++done_) {
        if (done_ >= max_units) return 1;
        if (threadIdx.x == 0) { int unit = -1;
            while (k < 8) { const int q = (grp + k) & 7; const unsigned p = __hip_atomic_fetch_add(qh + 64 * q, 1u, __ATOMIC_RELAXED, __HIP_MEMORY_SCOPE_AGENT); if (p < 64u) { unit = q * 64 + (int)p; break; } ++k; }
            bc[0] = (unsigned)unit; }
        __syncthreads();
        const int p = (int)bc[0];
        __syncthreads();
        if (p < 0) return 0;
        const int bb = p >> 6, hh = 7 - ((p >> 3) & 7), j = p & 7;
        attn_unit(bb, hh, j, P, KM, qkn, gnorm, O, lds);
        attn_unit(bb, hh, 15 - j, P, KM, qkn, gnorm, O, lds);
    }
}
}
namespace rw {
using bf16x8 = __attribute__((ext_vector_type(8))) short;
using s16x4 = __attribute__((ext_vector_type(4))) short;
using f32x16 = __attribute__((ext_vector_type(16))) float;
using u32x4 = __attribute__((ext_vector_type(4))) unsigned;
using u32x2 = __attribute__((ext_vector_type(2))) unsigned;
#define RMFMA(a, b, c) __builtin_amdgcn_mfma_f32_32x32x16_bf16(a, b, c, 0, 0, 0)
typedef __attribute__((address_space(3))) const char* lds_cptr;
typedef __attribute__((address_space(3))) char* lds_ptr;
typedef short v4i16_t __attribute__((ext_vector_type(4)));
typedef float f32x2_t __attribute__((ext_vector_type(2))); typedef __bf16 bf16x2_t __attribute__((ext_vector_type(2)));
__device__ __forceinline__ unsigned cvtpk(float lo, float hi) { f32x2_t v = {lo, hi}; bf16x2_t b = __builtin_convertvector(v, bf16x2_t); return __builtin_bit_cast(unsigned, b); }
__device__ __forceinline__ int crow(int r, int hi) { return (r & 3) + 8 * (r >> 2) + 4 * hi; }
__device__ __forceinline__ s16x4 vtr(lds_cptr p) { return __builtin_bit_cast(s16x4, __builtin_amdgcn_ds_read_tr16_b64_v4i16((__attribute__((address_space(3))) v4i16_t*)p)); }
__device__ __forceinline__ bf16x8 pack8(const f32x16& x, int s) {
    return __builtin_bit_cast(bf16x8, (u32x4){cvtpk(x[8 * s], x[8 * s + 1]), cvtpk(x[8 * s + 2], x[8 * s + 3]), cvtpk(x[8 * s + 4], x[8 * s + 5]), cvtpk(x[8 * s + 6], x[8 * s + 7])}); }
__device__ __forceinline__ void fill_img(lds_ptr img, const bf16* g, int lane) {
    unsigned go = (unsigned)((lane >> 3) * 1024 + (lane & 7) * 16); const int ch = lane & 7; const lds_ptr ip = img + (ch >> 2) * 4096 + (lane >> 3) * 64 + (ch & 3) * 16;
#pragma unroll
    for (int it = 0; it < 8; ++it) { const u32x4 w = *(const u32x4*)((const char*)g + go); go += 8192u; asm volatile("" : "+v"(go));
        *(__attribute__((address_space(3))) u32x4*)(ip + it * 512) = w; }
}
__device__ __forceinline__ bf16x8 tr_frag(lds_cptr base  , int ct, int s) {
    const s16x4 lo = vtr(base + ct * 4096 + s * 1024), hi = vtr(base + ct * 4096 + s * 1024 + 512);
    return (bf16x8){lo[0], lo[1], lo[2], lo[3], hi[0], hi[1], hi[2], hi[3]}; }
__device__ __forceinline__ int tr_lane_off(int lane) { const int hi = lane >> 5; return ((lane >> 4) & 1) * 32 + (lane & 3) * 8 + (4 * hi + ((lane & 15) >> 2)) * 64; }
__device__ __forceinline__ bf16x8 row_frag(const bf16* g, int rt, int s, int lane) { const unsigned off = (unsigned)((32 * rt + (lane & 31)) * 1024 + 32 * s + 16 * (lane >> 5)); return *(const bf16x8*)((const char*)g + off); }

struct Bufs { bf16 *KK, *BT, *KT, *RT, *V, *G; float* gamC; float* bonus; bf16* McT; float* GcT; unsigned* U0d; bf16* S0; };
}

__device__ __forceinline__ float row16_sum(float v) {
    v += __builtin_bit_cast(float, __builtin_amdgcn_update_dpp(0, __builtin_bit_cast(int, v), 0xB1, 0xf, 0xf, false));
    v += __builtin_bit_cast(float, __builtin_amdgcn_update_dpp(0, __builtin_bit_cast(int, v), 0x4E, 0xf, 0xf, false));
    v += __builtin_bit_cast(float, __builtin_amdgcn_update_dpp(0, __builtin_bit_cast(int, v), 0x141, 0xf, 0xf, false));
    v += __builtin_bit_cast(float, __builtin_amdgcn_update_dpp(0, __builtin_bit_cast(int, v), 0x140, 0xf, 0xf, false));
    return v;
}
__device__ __forceinline__ void p2_rwkv_prep2(Frame& F, const float* mu, const float* w0, const float* w2, const float* a0, const float* a2, const float* g2,
                                              const float* k_k, const float* k_a, const float* r_k, const rw::Bufs& O, int nrep) {
    typedef float f32x4_t __attribute__((ext_vector_type(4)));
    using rw::bf16x8; using rw::u32x4; using rw::u32x2;
    const bf16* PROJ = (const bf16*)(F.ws + WS_PROJ);
    const int c = F.tid, cl = F.lane & 15, q = F.lane >> 4, ch0 = 64 * F.wave + 4 * cl;
    bf16x8 bw[4], ba[4], bg[3][4];
#pragma unroll
    for (int nt = 0; nt < 4; ++nt) { const int ch = ch0 + nt; unsigned u[4];
#pragma unroll
        for (int e = 0; e < 4; ++e) u[e] = rw::cvtpk(w2[(8 * q + 2 * e) * 512 + ch], w2[(8 * q + 2 * e + 1) * 512 + ch]);
        bw[nt] = __builtin_bit_cast(bf16x8, (u32x4){u[0], u[1], u[2], u[3]});
#pragma unroll
        for (int e = 0; e < 4; ++e) u[e] = rw::cvtpk(a2[(8 * q + 2 * e) * 512 + ch], a2[(8 * q + 2 * e + 1) * 512 + ch]);
        ba[nt] = __builtin_bit_cast(bf16x8, (u32x4){u[0], u[1], u[2], u[3]});
#pragma unroll
        for (int s = 0; s < 3; ++s) {
#pragma unroll
            for (int e = 0; e < 4; ++e) u[e] = rw::cvtpk(g2[(32 * s + 8 * q + 2 * e) * 512 + ch], g2[(32 * s + 8 * q + 2 * e + 1) * 512 + ch]);
            bg[s][nt] = __builtin_bit_cast(bf16x8, (u32x4){u[0], u[1], u[2], u[3]}); } }
    constexpr int TB = 16, ROWB = XR_W * 2, BUFB = 17 * ROWB;
    LAS unsigned char* xbuf = F.lds + RING_OFF;
    LAS unsigned* lin = (LAS unsigned*)(F.lds + RING_OFF + 2 * BUFB);
    const unsigned lds0 = (unsigned)(uintptr_t)(F.lds + RING_OFF);
    auto issue = [&](int tb, int buf) {
        const int t0 = F.vcu * 128 + tb * TB;
        for (int r = F.wave; r < 17; r += NWAVES) { const int t = t0 - 1 + r; if (r == 0 && (t0 % SEQ) == 0) continue;
            const unsigned char* src = (const unsigned char*)(PROJ + (size_t)t * INW_PAD + XR_OFF) + F.lane * 16;
#pragma unroll
            for (int k = 0; k < 4; ++k) if (k * 1024 + F.lane * 16 < ROWB) att::glds16(src + k * 1024, (unsigned)__builtin_amdgcn_readfirstlane(lds0 + buf * BUFB + r * ROWB + k * 1024)); } };
    f32x4_t cumc = {0.f, 0.f, 0.f, 0.f};
    issue(0, 0);
    for (int rep = 0; rep < nrep; ++rep)
    for (int tb = 0; tb < 128 / TB; ++tb) {
        const int t0 = F.vcu * 128 + tb * TB; const int buf = tb & 1;
        asm volatile("s_waitcnt vmcnt(0)" ::: "memory");
        __syncthreads();
        if (tb + 1 < 128 / TB) issue(tb + 1, buf ^ 1); else if (rep + 1 < nrep) issue(0, buf ^ 1);
        const LAS unsigned short* xb = (const LAS unsigned short*)(xbuf + buf * BUFB);
        for (int pq = c; pq < TB * 80; pq += NTHREADS) {
            const int i = pq / 80, j = pq - i * 80; const int t = t0 + i; const bool first = (t % SEQ) == 0;
            const unsigned wc = *(const LAS unsigned*)(xb + (i + 1) * (ROWB / 2) + 1536 + 2 * j), wp_ = *(const LAS unsigned*)(xb + i * (ROWB / 2) + 1536 + 2 * j);
            const float m0 = mu[1536 + 2 * j], m1 = mu[1536 + 2 * j + 1];
            const float c0 = bflo(wc), c1 = bfhi(wc), p0 = first ? 0.f : bflo(wp_), p1 = first ? 0.f : bfhi(wp_);
            const float x0 = c0 + (p0 - c0) * m0, x1 = c1 + (p1 - c1) * m1;
            float f0, f1; if (j < 16) { f0 = tanhf(x0); f1 = tanhf(x1); } else if (j < 32) { f0 = x0; f1 = x1; } else { f0 = __builtin_amdgcn_rcpf(1.0f + __expf(-x0)); f1 = __builtin_amdgcn_rcpf(1.0f + __expf(-x1)); }
            lin[i * 80 + j] = rw::cvtpk(f0, f1); }
        __syncthreads();
        if ((t0 & 63) == 0) cumc = (f32x4_t){0.f, 0.f, 0.f, 0.f};
        f32x4_t aW[4], aA[4];
        const unsigned ob = (unsigned)(t0 + 4 * q) * 1024u + (unsigned)ch0 * 2u;
        {
            f32x4_t aG[4];
            const f32x4_t w0c = *(const f32x4_t*)(w0 + ch0), a0c = *(const f32x4_t*)(a0 + ch0);
            const LAS unsigned char* lp = (const LAS unsigned char*)lin + cl * 320 + q * 16;
            const bf16x8 fw = *(const LAS bf16x8*)(lp), fa = *(const LAS bf16x8*)(lp + 64), fg0 = *(const LAS bf16x8*)(lp + 128), fg1 = *(const LAS bf16x8*)(lp + 192), fg2 = *(const LAS bf16x8*)(lp + 256);
#pragma unroll
            for (int nt = 0; nt < 4; ++nt) {
                aW[nt] = __builtin_amdgcn_mfma_f32_16x16x32_bf16(fw, bw[nt], (f32x4_t){w0c[nt], w0c[nt], w0c[nt], w0c[nt]}, 0, 0, 0);
                aA[nt] = __builtin_amdgcn_mfma_f32_16x16x32_bf16(fa, ba[nt], (f32x4_t){a0c[nt], a0c[nt], a0c[nt], a0c[nt]}, 0, 0, 0);
                f32x4_t g_ = __builtin_amdgcn_mfma_f32_16x16x32_bf16(fg0, bg[0][nt], (f32x4_t){0.f, 0.f, 0.f, 0.f}, 0, 0, 0);
                g_ = __builtin_amdgcn_mfma_f32_16x16x32_bf16(fg1, bg[1][nt], g_, 0, 0, 0);
                aG[nt] = __builtin_amdgcn_mfma_f32_16x16x32_bf16(fg2, bg[2][nt], g_, 0, 0, 0); }
#pragma unroll
            for (int j = 0; j < 4; ++j) *(u32x2*)((char*)O.G + ob + j * 1024) = (u32x2){rw::cvtpk(aG[0][j], aG[1][j]), rw::cvtpk(aG[2][j], aG[3][j])};
        }
        f32x4_t cum[4]; float lw0[4];
#pragma unroll
        for (int nt = 0; nt < 4; ++nt) {
            f32x4_t lw;
#pragma unroll
            for (int j = 0; j < 4; ++j) { lw[j] = -DECAY_SCALE * __builtin_amdgcn_rcpf(1.0f + __expf(-aW[nt][j])); aA[nt][j] = __builtin_amdgcn_rcpf(1.0f + __expf(-aA[nt][j])); }
            const float p0 = lw[0], p1 = p0 + lw[1], p2 = p1 + lw[2], p3 = p2 + lw[3];
            const unsigned s_ = __builtin_bit_cast(unsigned, p3);
            auto s16 = __builtin_amdgcn_permlane16_swap(s_, s_, false, false);
            const float A_ = __builtin_bit_cast(float, (unsigned)s16[0]), pr = A_ + __builtin_bit_cast(float, (unsigned)s16[1]);
            const unsigned pr_ = __builtin_bit_cast(unsigned, pr);
            auto s32 = __builtin_amdgcn_permlane32_swap(pr_, pr_, false, false);
            const float C_ = __builtin_bit_cast(float, (unsigned)s32[0]), tot = C_ + __builtin_bit_cast(float, (unsigned)s32[1]);
            const float base = cumc[nt] + ((q & 1) ? A_ : 0.f) + ((q & 2) ? C_ : 0.f);
            cum[nt] = (f32x4_t){base + p0, base + p1, base + p2, base + p3}; lw0[nt] = lw[0];
            cumc[nt] += tot;
        }
        const LAS unsigned char* xr = (const LAS unsigned char*)xb + (4 * q) * ROWB + ch0 * 2;
        u32x2 rp2 = *(const LAS u32x2*)(xr), kp2 = *(const LAS u32x2*)(xr + 1024), vp2 = *(const LAS u32x2*)(xr + 2048);
        if (q == 0 && (t0 % SEQ) == 0) { rp2 = (u32x2){0u, 0u}; kp2 = (u32x2){0u, 0u}; vp2 = (u32x2){0u, 0u}; }
        const f32x4_t mu_r = *(const f32x4_t*)(mu + ch0), mu_k = *(const f32x4_t*)(mu + 512 + ch0), mu_v = *(const f32x4_t*)(mu + 1024 + ch0);
        const f32x4_t kkc = *(const f32x4_t*)(k_k + ch0), kac = *(const f32x4_t*)(k_a + ch0), rkc = *(const f32x4_t*)(r_k + ch0);
#define PX_EL(w2_, nt_) (((nt_) & 1) ? bfhi((w2_)[(nt_) >> 1]) : bflo((w2_)[(nt_) >> 1]))
#pragma unroll
        for (int j = 0; j < 4; ++j) {
            const int t = t0 + 4 * q + j;
            const u32x2 rc2 = *(const LAS u32x2*)(xr + (j + 1) * ROWB), kc2 = *(const LAS u32x2*)(xr + (j + 1) * ROWB + 1024), vc2 = *(const LAS u32x2*)(xr + (j + 1) * ROWB + 2048);
            float r_[4], k2_[4], kk_[4], v_[4]; float ss = 0.f, bs = 0.f;
#pragma unroll
            for (int nt = 0; nt < 4; ++nt) {
                const float rc_ = PX_EL(rc2, nt), rp_ = PX_EL(rp2, nt), kc_ = PX_EL(kc2, nt), kp_ = PX_EL(kp2, nt), vc_ = PX_EL(vc2, nt), vp_ = PX_EL(vp2, nt);
                const float r = rc_ + (rp_ - rc_) * mu_r[nt], k = kc_ + (kp_ - kc_) * mu_k[nt]; v_[nt] = vc_ + (vp_ - vc_) * mu_v[nt];
                const float kk = k * kkc[nt]; ss += kk * kk;
                const float k2 = k * (1.0f + (aA[nt][j] - 1.0f) * kac[nt]); bs += r * k2 * rkc[nt];
                r_[nt] = r; k2_[nt] = k2; kk_[nt] = kk; }
            ss = row16_sum(ss); bs = row16_sum(bs);
            const float rn = __builtin_amdgcn_rsqf(fmaxf(ss, 1e-24f));
            float oKK[4], oBT[4], oKT[4], oRT[4];
#pragma unroll
            for (int nt = 0; nt < 4; ++nt) {
                const float ecur = __expf(cum[nt][j]), einv = __builtin_amdgcn_rcpf(ecur);
                float eprev; if (j == 0) eprev = __expf(cum[nt][0] - lw0[nt]); else eprev = cum[nt][j - 1];
                const float kk = kk_[nt] * rn;
                oKK[nt] = kk * eprev; oBT[nt] = kk * aA[nt][j] * einv; oKT[nt] = k2_[nt] * einv; oRT[nt] = r_[nt] * ecur; cum[nt][j] = ecur; }
            rp2 = rc2; kp2 = kc2; vp2 = vc2;
            const unsigned o = ob + (unsigned)j * 1024u;
            *(u32x2*)((char*)O.KK + o) = (u32x2){rw::cvtpk(oKK[0], oKK[1]), rw::cvtpk(oKK[2], oKK[3])};
            *(u32x2*)((char*)O.BT + o) = (u32x2){rw::cvtpk(oBT[0], oBT[1]), rw::cvtpk(oBT[2], oBT[3])};
            *(u32x2*)((char*)O.KT + o) = (u32x2){rw::cvtpk(oKT[0], oKT[1]), rw::cvtpk(oKT[2], oKT[3])};
            *(u32x2*)((char*)O.RT + o) = (u32x2){rw::cvtpk(oRT[0], oRT[1]), rw::cvtpk(oRT[2], oRT[3])};
            *(u32x2*)((char*)O.V + o) = (u32x2){rw::cvtpk(v_[0], v_[1]), rw::cvtpk(v_[2], v_[3])};
            if (cl == 0) O.bonus[(size_t)t * 8 + F.wave] = bs;
        }
#undef PX_EL
        if ((t0 & 63) == 48 && q == 3) *(f32x4_t*)(O.gamC + (size_t)(t0 >> 6) * 512 + ch0) = (f32x4_t){cum[0][3], cum[1][3], cum[2][3], cum[3][3]};
    }
    asm volatile("s_waitcnt vmcnt(0)" ::: "memory");
    __syncthreads();
}
namespace rw {
__device__ __forceinline__ void fill_img_dma(unsigned lds_u, const bf16* g, int lane) {
    const char* src = (const char*)g + (unsigned)((lane >> 2) * 1024 + (lane & 3) * 16);
#pragma unroll
    for (int k = 0; k < 8; ++k) att::glds16(src + (k & 3) * 16384 + (k >> 2) * 64, (unsigned)__builtin_amdgcn_readfirstlane(lds_u + k * 1024));
}
__device__ __forceinline__ bf16x8 img_row_frag(lds_cptr img, int rt, int s, int lane) {
    return *(const __attribute__((address_space(3))) bf16x8*)(img + (s >> 1) * 4096 + (s & 1) * 32 + (lane >> 5) * 16 + (32 * rt + (lane & 31)) * 64); }
template <bool DRY> __device__ __forceinline__ void r1_chunk(int u, const Bufs& B, lds_ptr lds) {
    int tid = threadIdx.x; asm volatile("" : "+v"(tid));
    const int lane = tid & 63, l31 = lane & 31, hi = lane >> 5;
    const int bh = u >> 6, n = u & 63, b = bh >> 3, h = bh & 7;
    const size_t row0 = (size_t)b * SEQ + n * 64; const int col0 = h * 64;
    const size_t toff = row0 * 512 + col0;
    bf16* KKg = B.KK + toff; const bf16* BTg = B.BT + toff; const bf16* KTg = B.KT + toff; const bf16* Vg = B.V + toff;
    const lds_ptr img0 = lds, img1 = lds + 8192;
    const lds_cptr tr0 = (lds_cptr)img0 + tr_lane_off(lane);
    const unsigned lds_u = (unsigned)(uintptr_t)lds;
    fill_img_dma(lds_u, Vg, lane); fill_img_dma(lds_u + 24576, KKg, lane); fill_img_dma(lds_u + 8192, KTg, lane); fill_img_dma(lds_u + 16384, BTg, lane);
    asm volatile("s_waitcnt vmcnt(0)" ::: "memory");
    bf16x8 kkf[2][4], af[2][4];
#pragma unroll
    for (int rt = 0; rt < 2; ++rt)
#pragma unroll
        for (int s = 0; s < 4; ++s) { kkf[rt][s] = img_row_frag((lds_cptr)lds + 24576, rt, s, lane); af[rt][s] = img_row_frag((lds_cptr)lds + 8192, rt, s, lane); }
    f32x16 x00 = f32x16{}, x01 = f32x16{}, x11 = f32x16{};
#pragma unroll
    for (int s = 0; s < 4; ++s) { x00 = RMFMA(af[0][s], kkf[0][s], x00); x01 = RMFMA(af[0][s], kkf[1][s], x01); x11 = RMFMA(af[1][s], kkf[1][s], x11); }
#pragma unroll
    for (int r = 0; r < 16; ++r) { const bool keep = crow(r, hi) < l31; x00[r] = keep ? x00[r] : 0.f; x11[r] = keep ? x11[r] : 0.f; }
    asm volatile("s_waitcnt lgkmcnt(0)" ::: "memory");
    bf16x8 avf[2][4];
    {
        bf16x8 vf[2][4];
#pragma unroll
        for (int dt = 0; dt < 2; ++dt)
#pragma unroll
            for (int s = 0; s < 4; ++s) vf[dt][s] = tr_frag(tr0, dt, s);
        const bf16x8 p00 = pack8(x00, 0), p01 = pack8(x00, 1), p10 = pack8(x01, 0), p11 = pack8(x01, 1), p12 = pack8(x11, 0), p13 = pack8(x11, 1);
#pragma unroll
        for (int dt = 0; dt < 2; ++dt) {
            f32x16 a0 = f32x16{}, a1 = f32x16{};
            a0 = RMFMA(p00, vf[dt][0], a0); a0 = RMFMA(p01, vf[dt][1], a0);
            a1 = RMFMA(p10, vf[dt][0], a1); a1 = RMFMA(p11, vf[dt][1], a1); a1 = RMFMA(p12, vf[dt][2], a1); a1 = RMFMA(p13, vf[dt][3], a1);
            avf[dt][0] = pack8(a0, 0); avf[dt][1] = pack8(a0, 1); avf[dt][2] = pack8(a1, 0); avf[dt][3] = pack8(a1, 1);
        }
    }
#pragma unroll
    for (int rt = 0; rt < 2; ++rt)
#pragma unroll
        for (int s = 0; s < 4; ++s) af[rt][s] = img_row_frag((lds_cptr)lds + 16384, rt, s, lane);
    x00 = f32x16{}; x01 = f32x16{}; x11 = f32x16{};
#pragma unroll
    for (int s = 0; s < 4; ++s) { x00 = RMFMA(af[0][s], kkf[0][s], x00); x01 = RMFMA(af[0][s], kkf[1][s], x01); x11 = RMFMA(af[1][s], kkf[1][s], x11); }
    {
        __attribute__((address_space(3))) float* L = (__attribute__((address_space(3))) float*)img1;
#pragma unroll
        for (int q = 0; q < 4; ++q) {
            *(__attribute__((address_space(3))) f32x4*)(L + (l31) * 64 + 8 * q + 4 * hi) = (f32x4){x00[4 * q], x00[4 * q + 1], x00[4 * q + 2], x00[4 * q + 3]};
            *(__attribute__((address_space(3))) f32x4*)(L + (32 + l31) * 64 + 8 * q + 4 * hi) = (f32x4){x01[4 * q], x01[4 * q + 1], x01[4 * q + 2], x01[4 * q + 3]};
            *(__attribute__((address_space(3))) f32x4*)(L + (32 + l31) * 64 + 32 + 8 * q + 4 * hi) = (f32x4){x11[4 * q], x11[4 * q + 1], x11[4 * q + 2], x11[4 * q + 3]};
        }
    }
    asm volatile("s_waitcnt lgkmcnt(0)" ::: "memory");
    __builtin_amdgcn_sched_barrier(0);
    float y[64];
#pragma unroll
    for (int i = 0; i < 64; ++i) y[i] = (i == lane) ? 1.f : 0.f;
    {
        const __attribute__((address_space(3))) float* L = (const __attribute__((address_space(3))) float*)img1;
#pragma unroll
        for (int j = 63; j >= 1; --j) {
#pragma unroll
            for (int i4 = 0; i4 < j; i4 += 4) { const f32x4 a = *(const __attribute__((address_space(3))) f32x4*)(L + j * 64 + i4);
                y[i4] -= y[j] * a[0]; if (i4 + 1 < j) y[i4 + 1] -= y[j] * a[1]; if (i4 + 2 < j) y[i4 + 2] -= y[j] * a[2]; if (i4 + 3 < j) y[i4 + 3] -= y[j] * a[3];
                if ((i4 & 12) == 12) asm volatile("" ::: "memory"); }
            asm volatile("" ::: "memory");
        }
    }
    bf16x8 tn[2][4];
#pragma unroll
    for (int s = 0; s < 4; ++s) {
        unsigned wa[4], wb[4];
#pragma unroll
        for (int jj = 0; jj < 4; ++jj) { const int j = 2 * jj, i0 = 16 * s + 8 * (j >> 2) + (j & 3);
            const unsigned a = cvtpk(-y[i0], -y[i0 + 1]), bq = cvtpk(-y[i0 + 4], -y[i0 + 5]);
            auto rr = __builtin_amdgcn_permlane32_swap(a, bq, false, false); wa[jj] = rr[0]; wb[jj] = rr[1]; }
        tn[0][s] = __builtin_bit_cast(bf16x8, (u32x4){wa[0], wa[1], wa[2], wa[3]}); tn[1][s] = __builtin_bit_cast(bf16x8, (u32x4){wb[0], wb[1], wb[2], wb[3]});
    }
    int tid2 = threadIdx.x; asm volatile("" : "+v"(tid2));
#define lane (tid2 & 63)
#define l31 (tid2 & 31)
#define hi ((tid2 >> 5) & 1)
    asm volatile("s_waitcnt lgkmcnt(0)" ::: "memory");
    fill_img_dma((unsigned)(uintptr_t)lds + 8192, BTg, lane);
    const lds_cptr tr0b = (lds_cptr)img0 + tr_lane_off(lane);
    bf16x8 u0f[2][4];
    {
        unsigned* ud = B.U0d + (size_t)u * 2048;
#pragma unroll
        for (int dt = 0; dt < 2; ++dt) { f32x16 a0 = f32x16{}, a1 = f32x16{};
            a0 = RMFMA(tn[0][0], avf[dt][0], a0); a0 = RMFMA(tn[0][1], avf[dt][1], a0);
#pragma unroll
            for (int s = 0; s < 4; ++s) a1 = RMFMA(tn[1][s], avf[dt][s], a1);
#pragma unroll
            for (int r2 = 0; r2 < 8; ++r2) { *(unsigned*)((char*)ud + (unsigned)((((0 * 2 + dt) * 8 + r2) * 64 + lane) * 4)) = cvtpk(a0[2 * r2], a0[2 * r2 + 1]); *(unsigned*)((char*)ud + (unsigned)((((1 * 2 + dt) * 8 + r2) * 64 + lane) * 4)) = cvtpk(a1[2 * r2], a1[2 * r2 + 1]); }
            u0f[dt][0] = pack8(a0, 0); u0f[dt][1] = pack8(a0, 1); u0f[dt][2] = pack8(a1, 0); u0f[dt][3] = pack8(a1, 1); }
    }
    const lds_ptr img2 = lds + 24576;
    const lds_cptr trk = (lds_cptr)img2 + tr_lane_off(lane);
    bf16x8 nwa[2][4];
#pragma unroll
    for (int ct = 0; ct < 2; ++ct) { f32x16 a0 = f32x16{}, a1 = f32x16{};
        bf16x8 kb[4];
#pragma unroll
        for (int s = 0; s < 4; ++s) kb[s] = tr_frag(trk, ct, s);
        a0 = RMFMA(tn[0][0], kb[0], a0); a0 = RMFMA(tn[0][1], kb[1], a0);
#pragma unroll
        for (int s = 0; s < 4; ++s) a1 = RMFMA(tn[1][s], kb[s], a1);
        {
            __attribute__((address_space(3))) unsigned short* sg = (__attribute__((address_space(3))) unsigned short*)(lds + 16384) + 32 * ct + l31;
#pragma unroll
            for (int r = 0; r < 16; ++r) { sg[crow(r, hi) * 64] = (unsigned short)(cvtpk(a0[r], 0.f) & 0xffffu); sg[(32 + crow(r, hi)) * 64] = (unsigned short)(cvtpk(a1[r], 0.f) & 0xffffu); } }
        nwa[ct][0] = pack8(a0, 0); nwa[ct][1] = pack8(a0, 1); nwa[ct][2] = pack8(a1, 0); nwa[ct][3] = pack8(a1, 1); }
    asm volatile("s_waitcnt lgkmcnt(0)" ::: "memory");
    {
        bf16* gp = KKg + (size_t)(lane >> 3) * 512 + (lane & 7) * 8; lds_cptr sp = (lds_cptr)lds + 16384 + (lane >> 3) * 128 + (lane & 7) * 16;
#pragma unroll
        for (int it = 0; it < 8; ++it) { const u32x4 w_ = *(const __attribute__((address_space(3))) u32x4*)(sp + it * 1024); if (!DRY) *(u32x4*)gp = w_; else asm volatile("" :: "v"(w_)); gp += 8 * 512; asm volatile("" : "+v"(gp)); }
    }
    asm volatile("s_waitcnt lgkmcnt(0)" ::: "memory");
    fill_img_dma((unsigned)(uintptr_t)lds + 16384, KTg, lane);
    asm volatile("s_waitcnt vmcnt(8)" ::: "memory");
    const lds_cptr tr1 = (lds_cptr)img1 + tr_lane_off(lane);
    bf16x8 bsf[2][4];
#pragma unroll
    for (int ct = 0; ct < 2; ++ct)
#pragma unroll
        for (int s = 0; s < 4; ++s) bsf[ct][s] = tr_frag(tr1, ct, s);
    {
        const float gC0 = B.gamC[(row0 >> 6) * 512 + col0 + l31], gC1 = B.gamC[(row0 >> 6) * 512 + col0 + 32 + l31];
        unsigned char* r2d = (unsigned char*)B.McT + (size_t)u * 16384;
        f32x16 m[2][2];
#pragma unroll
        for (int cpt = 0; cpt < 2; ++cpt)
#pragma unroll
            for (int ct = 0; ct < 2; ++ct) {
                f32x16 mm = f32x16{};
#pragma unroll
                for (int s = 0; s < 4; ++s) mm = RMFMA(nwa[cpt][s], bsf[ct][s], mm);
                const float gc = ct ? gC1 : gC0;
#pragma unroll
                for (int r = 0; r < 16; ++r) { float v = mm[r]; if (cpt == ct) v += (crow(r, hi) == l31) ? 1.f : 0.f; mm[r] = v * gc; }
                m[cpt][ct] = mm;
            }
#pragma unroll
        for (int ct = 0; ct < 2; ++ct)
#pragma unroll
            for (int s = 0; s < 4; ++s) *(bf16x8*)(r2d + (unsigned)(((ct * 4 + s) * 64 + lane) * 16)) = pack8(m[s >> 1][ct], s & 1);
    }
    asm volatile("s_waitcnt vmcnt(0)" ::: "memory");
    {
        const lds_cptr tr2 = tr1 + 8192;
        unsigned char* gd = (unsigned char*)B.McT + (size_t)u * 16384 + 8192;
        const float* gcv = B.gamC + (row0 >> 6) * 512 + col0;
#pragma unroll
        for (int ct = 0; ct < 2; ++ct) {
            bf16x8 ka[4];
#pragma unroll
            for (int s = 0; s < 4; ++s) ka[s] = tr_frag(tr2, ct, s);
#pragma unroll
            for (int dt = 0; dt < 2; ++dt) {
                f32x16 g = f32x16{};
#pragma unroll
                for (int s = 0; s < 4; ++s) { g = RMFMA(bsf[ct][s], u0f[dt][s], g); g = RMFMA(ka[s], tr_frag(tr0b, dt, s), g); }
#pragma unroll
                for (int r = 0; r < 16; ++r) g[r] *= gcv[32 * ct + crow(r, hi)];
                *(u32x4*)(gd + (unsigned)((((dt * 2 + ct) * 2 + 0) * 64 + lane) * 16)) = (u32x4){cvtpk(g[0], g[1]), cvtpk(g[2], g[3]), cvtpk(g[4], g[5]), cvtpk(g[6], g[7])};
                *(u32x4*)(gd + (unsigned)((((dt * 2 + ct) * 2 + 1) * 64 + lane) * 16)) = (u32x4){cvtpk(g[8], g[9]), cvtpk(g[10], g[11]), cvtpk(g[12], g[13]), cvtpk(g[14], g[15])};
            }
        }
    }
    asm volatile("s_waitcnt lgkmcnt(0)" ::: "memory");
#undef lane
#undef l31
#undef hi
}
}
namespace rw {
struct R2Set { bf16x8 m[2][4]; u32x4 g[2][2]; };
__device__ __forceinline__ void r2_load(R2Set& S, const unsigned char* blk, int dt, int lane) {
#pragma unroll
    for (int ct = 0; ct < 2; ++ct) {
#pragma unroll
        for (int s = 0; s < 4; ++s) S.m[ct][s] = *(const bf16x8*)(blk + (unsigned)(((ct * 4 + s) * 64 + lane) * 16));
#pragma unroll
        for (int hf = 0; hf < 2; ++hf) S.g[ct][hf] = *(const u32x4*)(blk + 8192 + (unsigned)((((dt * 2 + ct) * 2 + hf) * 64 + lane) * 16)); }
}
__device__ __forceinline__ f32x16 r2_unpack(const u32x4& a, const u32x4& b) {
    f32x16 x; x[0] = bflo(a.x); x[1] = bfhi(a.x); x[2] = bflo(a.y); x[3] = bfhi(a.y); x[4] = bflo(a.z); x[5] = bfhi(a.z); x[6] = bflo(a.w); x[7] = bfhi(a.w);
    x[8] = bflo(b.x); x[9] = bfhi(b.x); x[10] = bflo(b.y); x[11] = bfhi(b.y); x[12] = bflo(b.z); x[13] = bfhi(b.z); x[14] = bflo(b.w); x[15] = bfhi(b.w); return x; }
__device__ __forceinline__ void r2_step(const R2Set& S, f32x16& st0, f32x16& st1, bf16* s0row, int hi) {
#pragma unroll
    for (int q = 0; q < 4; ++q) { *(u32x2*)(s0row + 8 * q + 4 * hi) = (u32x2){cvtpk(st0[4 * q], st0[4 * q + 1]), cvtpk(st0[4 * q + 2], st0[4 * q + 3])};
        *(u32x2*)(s0row + 32 + 8 * q + 4 * hi) = (u32x2){cvtpk(st1[4 * q], st1[4 * q + 1]), cvtpk(st1[4 * q + 2], st1[4 * q + 3])}; }
    const bf16x8 x0 = pack8(st0, 0), x1 = pack8(st0, 1), x2 = pack8(st1, 0), x3 = pack8(st1, 1);
    f32x16 n0 = r2_unpack(S.g[0][0], S.g[0][1]), n1 = r2_unpack(S.g[1][0], S.g[1][1]);
    n0 = RMFMA(S.m[0][0], x0, n0); n1 = RMFMA(S.m[1][0], x0, n1); n0 = RMFMA(S.m[0][1], x1, n0); n1 = RMFMA(S.m[1][1], x1, n1);
    n0 = RMFMA(S.m[0][2], x2, n0); n1 = RMFMA(S.m[1][2], x2, n1); n0 = RMFMA(S.m[0][3], x3, n0); n1 = RMFMA(S.m[1][3], x3, n1);
    st0 = n0; st1 = n1;
}
__device__ __forceinline__ void r2_chain(int bh, int dt, const Bufs& B) {
    int tid = threadIdx.x; asm volatile("" : "+v"(tid));
    const int lane = tid & 63, l31 = lane & 31, hi = lane >> 5;
    f32x16 st0 = f32x16{}, st1 = f32x16{};
    const unsigned char* blk = (const unsigned char*)B.McT + (size_t)bh * 64 * 16384;
    bf16* s0p = B.S0 + (size_t)bh * 64 * 4096 + (size_t)(32 * dt + l31) * 64;
    R2Set A, Bq, C;
    r2_load(A, blk, dt, lane); r2_load(Bq, blk + 16384, dt, lane); r2_load(C, blk + 2 * 16384, dt, lane);
    for (int n = 0; n < 63; n += 3) {
        r2_step(A, st0, st1, s0p + (size_t)n * 4096, hi);        if (n + 3 < 64) r2_load(A, blk + (size_t)(n + 3) * 16384, dt, lane);
        r2_step(Bq, st0, st1, s0p + (size_t)(n + 1) * 4096, hi); if (n + 4 < 64) r2_load(Bq, blk + (size_t)(n + 4) * 16384, dt, lane);
        r2_step(C, st0, st1, s0p + (size_t)(n + 2) * 4096, hi);  if (n + 5 < 64) r2_load(C, blk + (size_t)(n + 5) * 16384, dt, lane);
    }
    r2_step(A, st0, st1, s0p + (size_t)63 * 4096, hi);
}

__device__ __forceinline__ void r2_chain_dma(int bh, int dt, const Bufs& B, lds_ptr lds) {
    int tid = threadIdx.x; asm volatile("" : "+v"(tid));
    const int lane = tid & 63, l31 = lane & 31, hi = lane >> 5;
    const unsigned lds0 = (unsigned)(uintptr_t)lds;
    const unsigned char* blk = (const unsigned char*)B.McT + (size_t)bh * 64 * 16384 + lane * 16;
    unsigned char* s0g = (unsigned char*)B.S0 + (size_t)bh * 64 * 8192 + dt * 4096 + lane * 16;
#define R2D_ISSUE(g_) do { _Pragma("unroll") for (int s_ = 0; s_ < 4; ++s_) { const unsigned char* src_ = blk + (size_t)(4 * (g_) + s_) * 16384; const unsigned base_ = lds0 + ((g_) & 1) * 49152 + s_ * 12288; \
        _Pragma("unroll") for (int i_ = 0; i_ < 8; ++i_) att::glds16(src_ + i_ * 1024, (unsigned)__builtin_amdgcn_readfirstlane(base_ + i_ * 1024)); \
        _Pragma("unroll") for (int i_ = 0; i_ < 4; ++i_) att::glds16(src_ + 8192 + dt * 4096 + i_ * 1024, (unsigned)__builtin_amdgcn_readfirstlane(base_ + 8192 + i_ * 1024)); } } while (0)
    f32x16 st0 = f32x16{}, st1 = f32x16{};
    R2D_ISSUE(0);
    asm volatile("s_waitcnt vmcnt(0)" ::: "memory");
    for (int g = 0; g < 16; ++g) {
        if (g + 1 < 16) R2D_ISSUE(g + 1);
#pragma unroll
        for (int s = 0; s < 4; ++s) {
            const lds_cptr slot = (lds_cptr)lds + (g & 1) * 49152 + s * 12288 + lane * 16;
            const lds_ptr stg = lds + 98304 + s * 4096 + l31 * 128 + 8 * hi;
#pragma unroll
            for (int q = 0; q < 4; ++q) { *(__attribute__((address_space(3))) u32x2*)(stg + 16 * q) = (u32x2){cvtpk(st0[4 * q], st0[4 * q + 1]), cvtpk(st0[4 * q + 2], st0[4 * q + 3])};
                *(__attribute__((address_space(3))) u32x2*)(stg + 64 + 16 * q) = (u32x2){cvtpk(st1[4 * q], st1[4 * q + 1]), cvtpk(st1[4 * q + 2], st1[4 * q + 3])}; }
            R2Set S;
#pragma unroll
            for (int ct = 0; ct < 2; ++ct) {
#pragma unroll
                for (int k = 0; k < 4; ++k) S.m[ct][k] = *(const __attribute__((address_space(3))) bf16x8*)(slot + (ct * 4 + k) * 1024);
#pragma unroll
                for (int hf = 0; hf < 2; ++hf) S.g[ct][hf] = *(const __attribute__((address_space(3))) u32x4*)(slot + 8192 + (ct * 2 + hf) * 1024); }
            const bf16x8 x0 = pack8(st0, 0), x1 = pack8(st0, 1), x2 = pack8(st1, 0), x3 = pack8(st1, 1);
            f32x16 n0 = r2_unpack(S.g[0][0], S.g[0][1]), n1 = r2_unpack(S.g[1][0], S.g[1][1]);
            n0 = RMFMA(S.m[0][0], x0, n0); n1 = RMFMA(S.m[1][0], x0, n1); n0 = RMFMA(S.m[0][1], x1, n0); n1 = RMFMA(S.m[1][1], x1, n1);
            n0 = RMFMA(S.m[0][2], x2, n0); n1 = RMFMA(S.m[1][2], x2, n1); n0 = RMFMA(S.m[0][3], x3, n0); n1 = RMFMA(S.m[1][3], x3, n1);
            st0 = n0; st1 = n1;
        }
        asm volatile("s_waitcnt lgkmcnt(0)" ::: "memory");
#pragma unroll
        for (int s = 0; s < 4; ++s)
#pragma unroll
            for (int i = 0; i < 4; ++i) *(u32x4*)(s0g + (size_t)(4 * g + s) * 8192 + i * 1024) = *(const __attribute__((address_space(3))) u32x4*)((lds_cptr)lds + 98304 + s * 4096 + i * 1024 + lane * 16);
        asm volatile("s_waitcnt vmcnt(0) lgkmcnt(0)" ::: "memory");
    }
#undef R2D_ISSUE
}

__device__ __forceinline__ void r2_chain_wg(int bh, int dt, const Bufs& B, lds_ptr lds, int wave) {
    int tid = threadIdx.x; asm volatile("" : "+v"(tid));
    const int lane = tid & 63, l31 = lane & 31, hi = lane >> 5;
    const unsigned lds0 = (unsigned)(uintptr_t)lds;
    const unsigned char* blk = (const unsigned char*)B.McT + (size_t)bh * 64 * 16384 + lane * 16;
    unsigned char* s0g = (unsigned char*)B.S0 + (size_t)bh * 64 * 8192 + dt * 4096 + lane * 16;
    const bool loader = (wave >= 1 && wave <= 4);
#define R2W_DMA(g_) do { _Pragma("unroll") for (int k_ = 0; k_ < 6; ++k_) { const int q_ = (wave - 1) * 6 + k_, s_ = q_ / 12, j_ = q_ - 12 * s_; \
        const unsigned char* src_ = blk + (size_t)(2 * (g_) + s_) * 16384 + (j_ < 8 ? j_ * 1024 : 8192 + dt * 4096 + (j_ - 8) * 1024); \
        att::glds16(src_, (unsigned)__builtin_amdgcn_readfirstlane(lds0 + ((g_) & 3) * 24576 + s_ * 12288 + j_ * 1024)); } } while (0)
#define R2W_ST(g_) do { _Pragma("unroll") for (int k_ = 0; k_ < 2; ++k_) { const int id_ = (wave - 1) * 2 + k_, s_ = id_ >> 2, i_ = id_ & 3; \
        *(u32x4*)(s0g + (size_t)(2 * (g_) + s_) * 8192 + i_ * 1024) = *(const __attribute__((address_space(3))) u32x4*)((lds_cptr)lds + 98304 + ((g_) & 1) * 8192 + s_ * 4096 + i_ * 1024 + lane * 16); } } while (0)
    f32x16 st0 = f32x16{}, st1 = f32x16{};
    if (loader) { R2W_DMA(0); R2W_DMA(1); R2W_DMA(2); asm volatile("s_waitcnt vmcnt(12)" ::: "memory"); }
    for (int g = 0; g < 32; ++g) {
        __syncthreads();
        if (wave == 0) {
#pragma unroll
            for (int s = 0; s < 2; ++s) {
                const lds_cptr slot = (lds_cptr)lds + (g & 3) * 24576 + s * 12288 + lane * 16;
                const lds_ptr stg = lds + 98304 + (g & 1) * 8192 + s * 4096 + l31 * 128 + 8 * hi;
#pragma unroll
                for (int q = 0; q < 4; ++q) { *(__attribute__((address_space(3))) u32x2*)(stg + 16 * q) = (u32x2){cvtpk(st0[4 * q], st0[4 * q + 1]), cvtpk(st0[4 * q + 2], st0[4 * q + 3])};
                    *(__attribute__((address_space(3))) u32x2*)(stg + 64 + 16 * q) = (u32x2){cvtpk(st1[4 * q], st1[4 * q + 1]), cvtpk(st1[4 * q + 2], st1[4 * q + 3])}; }
                R2Set S;
#pragma unroll
                for (int ct = 0; ct < 2; ++ct) {
#pragma unroll
                    for (int k = 0; k < 4; ++k) S.m[ct][k] = *(const __attribute__((address_space(3))) bf16x8*)(slot + (ct * 4 + k) * 1024);
#pragma unroll
                    for (int hf = 0; hf < 2; ++hf) S.g[ct][hf] = *(const __attribute__((address_space(3))) u32x4*)(slot + 8192 + (ct * 2 + hf) * 1024); }
                const bf16x8 x0 = pack8(st0, 0), x1 = pack8(st0, 1), x2 = pack8(st1, 0), x3 = pack8(st1, 1);
                f32x16 n0 = r2_unpack(S.g[0][0], S.g[0][1]), n1 = r2_unpack(S.g[1][0], S.g[1][1]);
                n0 = RMFMA(S.m[0][0], x0, n0); n1 = RMFMA(S.m[1][0], x0, n1); n0 = RMFMA(S.m[0][1], x1, n0); n1 = RMFMA(S.m[1][1], x1, n1);
                n0 = RMFMA(S.m[0][2], x2, n0); n1 = RMFMA(S.m[1][2], x2, n1); n0 = RMFMA(S.m[0][3], x3, n0); n1 = RMFMA(S.m[1][3], x3, n1);
                st0 = n0; st1 = n1;
            }
            asm volatile("s_waitcnt lgkmcnt(0)" ::: "memory");
        } else if (loader) {
            if (g + 3 < 32) R2W_DMA(g + 3);
            if (g >= 1) R2W_ST(g - 1);
            if (g >= 3 && g <= 28) asm volatile("s_waitcnt vmcnt(18)" ::: "memory");
            else if (g == 0) asm volatile("s_waitcnt vmcnt(12)" ::: "memory");
            else if (g == 1) asm volatile("s_waitcnt vmcnt(14)" ::: "memory");
            else if (g == 2) asm volatile("s_waitcnt vmcnt(16)" ::: "memory");
            else if (g == 29) asm volatile("s_waitcnt vmcnt(12)" ::: "memory");
            else asm volatile("s_waitcnt vmcnt(6)" ::: "memory");
        }
    }
    __syncthreads();
    if (loader) { R2W_ST(31); asm volatile("s_waitcnt vmcnt(0)" ::: "memory"); }
#undef R2W_DMA
#undef R2W_ST
}
__device__ __forceinline__ void r3_chunk(int u, const Bufs& B, const float* ln_g, const float* ln_b, bf16* mix, lds_ptr lds) {
    int tid = threadIdx.x; asm volatile("" : "+v"(tid));
    const int lane = tid & 63, l31 = lane & 31, hi = lane >> 5;
    const int bh = u >> 6, n = u & 63, b = bh >> 3, h = bh & 7;
    const size_t row0 = (size_t)b * SEQ + n * 64; const int col0 = h * 64;
    const size_t toff = row0 * 512 + col0;
    const bf16* NWg = B.KK + toff; const bf16* BTg = B.BT + toff; const bf16* KTg = B.KT + toff; const bf16* RTg = B.RT + toff; const bf16* Vg = B.V + toff; const bf16* Gg = B.G + toff;
    const bf16* S0g = B.S0 + (size_t)u * 4096;
    fill_img(lds, Vg, lane);
    bf16x8 s0f[2][4];
#pragma unroll
    for (int dt = 0; dt < 2; ++dt)
#pragma unroll
        for (int s = 0; s < 4; ++s) s0f[dt][s] = *(const bf16x8*)(S0g + (size_t)(32 * dt + l31) * 64 + 16 * s + 8 * hi);
    bf16x8 uf[2][4];
    bf16x8 rf[2][4], abt[2][4], akt[2][4];
    {
        bf16x8 nwf[2][4];
#pragma unroll
        for (int it = 0; it < 2; ++it)
#pragma unroll
            for (int s = 0; s < 4; ++s) nwf[it][s] = row_frag(NWg, it, s, lane);
        const unsigned* ud = B.U0d + (size_t)u * 2048;
        unsigned uw[2][2][8];
#pragma unroll
        for (int dt = 0; dt < 2; ++dt)
#pragma unroll
            for (int r2 = 0; r2 < 8; ++r2) { uw[dt][0][r2] = ud[((0 * 2 + dt) * 8 + r2) * 64 + lane]; uw[dt][1][r2] = ud[((1 * 2 + dt) * 8 + r2) * 64 + lane]; }
#pragma unroll
        for (int tt = 0; tt < 2; ++tt)
#pragma unroll
            for (int s = 0; s < 4; ++s) { rf[tt][s] = row_frag(RTg, tt, s, lane); abt[tt][s] = row_frag(BTg, tt, s, lane); }
#pragma unroll
        for (int dt = 0; dt < 2; ++dt) {
            f32x16 a0, a1;
#pragma unroll
            for (int r2 = 0; r2 < 8; ++r2) { const unsigned w0 = uw[dt][0][r2], w1 = uw[dt][1][r2];
                a0[2 * r2] = bflo(w0); a0[2 * r2 + 1] = bfhi(w0); a1[2 * r2] = bflo(w1); a1[2 * r2 + 1] = bfhi(w1); }
#pragma unroll
            for (int s = 0; s < 4; ++s) { a0 = RMFMA(nwf[0][s], s0f[dt][s], a0); a1 = RMFMA(nwf[1][s], s0f[dt][s], a1); }
            uf[dt][0] = pack8(a0, 0); uf[dt][1] = pack8(a0, 1); uf[dt][2] = pack8(a1, 0); uf[dt][3] = pack8(a1, 1);
        }
    }
#pragma unroll
    for (int tt = 0; tt < 2; ++tt)
#pragma unroll
        for (int s = 0; s < 4; ++s) akt[tt][s] = row_frag(KTg, tt, s, lane);
    f32x16 o[2][2];
#pragma unroll
    for (int tt = 0; tt < 2; ++tt)
#pragma unroll
        for (int dt = 0; dt < 2; ++dt) { o[tt][dt] = f32x16{};
#pragma unroll
            for (int s = 0; s < 4; ++s) o[tt][dt] = RMFMA(rf[tt][s], s0f[dt][s], o[tt][dt]); }
    asm volatile("s_waitcnt lgkmcnt(0)" ::: "memory");
    const lds_cptr tr0 = (lds_cptr)lds + tr_lane_off(lane);
#pragma unroll
    for (int pass = 0; pass < 2; ++pass) {
        f32x16 x00 = f32x16{}, x01 = f32x16{}, x11 = f32x16{};
#pragma unroll
        for (int s = 0; s < 4; ++s) { const bf16x8 a0 = pass ? akt[0][s] : abt[0][s], a1 = pass ? akt[1][s] : abt[1][s];
            x00 = RMFMA(a0, rf[0][s], x00); x01 = RMFMA(a0, rf[1][s], x01); x11 = RMFMA(a1, rf[1][s], x11); }
#pragma unroll
        for (int r = 0; r < 16; ++r) { const bool keep = crow(r, hi) <= l31; x00[r] = keep ? x00[r] : 0.f; x11[r] = keep ? x11[r] : 0.f; }
        const bf16x8 p00 = pack8(x00, 0), p01 = pack8(x00, 1), p10 = pack8(x01, 0), p11 = pack8(x01, 1), p12 = pack8(x11, 0), p13 = pack8(x11, 1);
#pragma unroll
        for (int dt = 0; dt < 2; ++dt) {
            bf16x8 bb[4];
#pragma unroll
            for (int s = 0; s < 4; ++s) bb[s] = pass ? tr_frag(tr0, dt, s) : uf[dt][s];
            o[0][dt] = RMFMA(p00, bb[0], o[0][dt]); o[0][dt] = RMFMA(p01, bb[1], o[0][dt]);
            o[1][dt] = RMFMA(p10, bb[0], o[1][dt]); o[1][dt] = RMFMA(p11, bb[1], o[1][dt]); o[1][dt] = RMFMA(p12, bb[2], o[1][dt]); o[1][dt] = RMFMA(p13, bb[3], o[1][dt]);
        }
    }
    u32x4 vwp[8], gwp[8]; float bonp[8];
#pragma unroll
    for (int i = 0; i < 8; ++i) { const int t = i * 8 + (lane >> 3); bonp[i] = B.bonus[(row0 + t) * 8 + h];
        vwp[i] = *(const u32x4*)(Vg + (size_t)t * 512 + (lane & 7) * 8); gwp[i] = *(const u32x4*)(Gg + (size_t)t * 512 + (lane & 7) * 8); }
    __attribute__((address_space(3))) float* stg = (__attribute__((address_space(3))) float*)(lds + 8192);
#pragma unroll
    for (int tt = 0; tt < 2; ++tt)
#pragma unroll
        for (int dt = 0; dt < 2; ++dt)
#pragma unroll
            for (int r = 0; r < 16; ++r) stg[(32 * tt + crow(r, hi)) * 64 + 32 * dt + l31] = o[tt][dt][r];
    asm volatile("s_waitcnt lgkmcnt(0)" ::: "memory");
    const int ch = lane & 7;
    const f32x4 lg0 = *(const f32x4*)(ln_g + col0 + ch * 8), lg1 = *(const f32x4*)(ln_g + col0 + ch * 8 + 4), lb0 = *(const f32x4*)(ln_b + col0 + ch * 8), lb1 = *(const f32x4*)(ln_b + col0 + ch * 8 + 4);
#pragma unroll
    for (int i = 0; i < 8; ++i) { const int t = i * 8 + (lane >> 3);
        const f32x4 a = *(const __attribute__((address_space(3))) f32x4*)(stg + t * 64 + ch * 8), c = *(const __attribute__((address_space(3))) f32x4*)(stg + t * 64 + ch * 8 + 4);
        float sm = (a[0] + a[1]) + (a[2] + a[3]) + (c[0] + c[1]) + (c[2] + c[3]);
        sm += __shfl_xor(sm, 1); sm += __shfl_xor(sm, 2); sm += __shfl_xor(sm, 4);
        const float mean = sm * (1.f / 64.f);
        const f32x4 da = a - mean, dc = c - mean;
        float sq = (da[0] * da[0] + da[1] * da[1]) + (da[2] * da[2] + da[3] * da[3]) + (dc[0] * dc[0] + dc[1] * dc[1]) + (dc[2] * dc[2] + dc[3] * dc[3]);
        sq += __shfl_xor(sq, 1); sq += __shfl_xor(sq, 2); sq += __shfl_xor(sq, 4);
        const float rstd = 1.0f / sqrtf(sq * (1.f / 64.f) + GN_EPS);
        const float bon = bonp[i];
        const u32x4 vw = vwp[i], gw = gwp[i];
        float e[8];
        e[0] = (da[0] * rstd * lg0[0] + lb0[0] + bon * bflo(vw.x)) * bflo(gw.x); e[1] = (da[1] * rstd * lg0[1] + lb0[1] + bon * bfhi(vw.x)) * bfhi(gw.x);
        e[2] = (da[2] * rstd * lg0[2] + lb0[2] + bon * bflo(vw.y)) * bflo(gw.y); e[3] = (da[3] * rstd * lg0[3] + lb0[3] + bon * bfhi(vw.y)) * bfhi(gw.y);
        e[4] = (dc[0] * rstd * lg1[0] + lb1[0] + bon * bflo(vw.z)) * bflo(gw.z); e[5] = (dc[1] * rstd * lg1[1] + lb1[1] + bon * bfhi(vw.z)) * bfhi(gw.z);
        e[6] = (dc[2] * rstd * lg1[2] + lb1[2] + bon * bflo(vw.w)) * bflo(gw.w); e[7] = (dc[3] * rstd * lg1[3] + lb1[3] + bon * bfhi(vw.w)) * bfhi(gw.w);
        *(u32x4*)(mix + (row0 + t) * INW_PAD + 512 + col0 + ch * 8) = (u32x4){cvtpk(e[0], e[1]), cvtpk(e[2], e[3]), cvtpk(e[4], e[5]), cvtpk(e[6], e[7])};
    }
    asm volatile("s_waitcnt lgkmcnt(0)" ::: "memory");
}
#undef RMFMA
}
__device__ __forceinline__ float bfly32(float (&a)[32], int lane) {
#pragma unroll
    for (int i = 0; i < 16; ++i) { const bool up = (lane & 32) != 0; const float send = up ? a[i] : a[16 + i], keep = up ? a[16 + i] : a[i]; a[i] = keep + __shfl_xor(send, 32); }
#pragma unroll
    for (int i = 0; i < 8; ++i) { const bool up = (lane & 16) != 0; const float send = up ? a[i] : a[8 + i], keep = up ? a[8 + i] : a[i]; a[i] = keep + __shfl_xor(send, 16); }
#pragma unroll
    for (int i = 0; i < 4; ++i) { const bool up = (lane & 8) != 0; const float send = up ? a[i] : a[4 + i], keep = up ? a[4 + i] : a[i]; a[i] = keep + __shfl_xor(send, 8); }
#pragma unroll
    for (int i = 0; i < 2; ++i) { const bool up = (lane & 4) != 0; const float send = up ? a[i] : a[2 + i], keep = up ? a[2 + i] : a[i]; a[i] = keep + __shfl_xor(send, 4); }
    { const bool up = (lane & 2) != 0; const float send = up ? a[0] : a[1], keep = up ? a[1] : a[0]; a[0] = keep + __shfl_xor(send, 2); }
    return a[0] + __shfl_xor(a[0], 1);
}
typedef float f32x4_r __attribute__((ext_vector_type(4)));
__device__ __forceinline__ unsigned p6_cvt(float lo, float hi) { typedef float f2 __attribute__((ext_vector_type(2))); typedef __bf16 b2 __attribute__((ext_vector_type(2))); f2 v = {lo, hi}; b2 b = __builtin_convertvector(v, b2); return __builtin_bit_cast(unsigned, b); }
__device__ __forceinline__ void p6_router_images(Frame& F, const float* g_ffn, const float* w_router) {
    unsigned char* wh = F.ws + WS_ROUT; unsigned char* wl = wh + 65536;
    for (int i = (F.vcu * NTHREADS + F.tid); i < 1024 * 32; i += F.G * NTHREADS) { const int k = i >> 5, e = i & 31; const float v = w_router[i] * g_ffn[k];
        const unsigned hb = f2bf(v); const float lo = v - __builtin_bit_cast(float, hb << 16); const unsigned lb = f2bf(lo);
        const int chunk = k >> 3, pc = (chunk & ~15) | ((chunk & 15) ^ (e & 15)); const int off = e * 2048 + pc * 16 + (k & 7) * 2;
        *(unsigned short*)(wh + off) = (unsigned short)hb; *(unsigned short*)(wl + off) = (unsigned short)lb; }
}
__device__ __forceinline__ void p6_router(Frame& F, const float* g_ffn, const float* w_router, const float* b_router) {
    LAS unsigned char* wh = F.lds + RING_OFF; LAS unsigned char* wl = wh + 65536;
    volatile LAS int* hist = (volatile LAS int*)(F.lds + LDSCTL_OFF);
    LAS float* wst = (LAS float*)(F.lds + LDSCTL_OFF + 1024) + F.wave * 320;
    {
        const unsigned char* img = F.ws + WS_ROUT + F.lane * 16; const unsigned lds_u = (unsigned)(uintptr_t)wh;
#pragma unroll
        for (int k = 0; k < 16; ++k) att::glds16(img + (k * 8 + F.wave) * 1024, (unsigned)__builtin_amdgcn_readfirstlane(lds_u + (k * 8 + F.wave) * 1024));
    }
    if (F.tid < 32) hist[F.tid] = 0;
    asm volatile("s_waitcnt vmcnt(0)" ::: "memory");
    __syncthreads();
    const bf16* hbuf = (const bf16*)(F.ws + WS_WD); unsigned char* XN2 = (unsigned char*)F.out;
    int* tope = (int*)(F.ws + WS_TAB + TAB_TOPE); float* topg = (float*)(F.ws + WS_TAB + TAB_TOPG);
    const int t0 = F.vcu * 128 + F.wave * 16;
    LAS float* gst = (LAS float*)(F.lds + LDSCTL_OFF + 11264);
    gst[F.tid] = g_ffn[F.tid]; gst[512 + F.tid] = g_ffn[512 + F.tid];
    f32x4_r acc0 = {0.f, 0.f, 0.f, 0.f}, acc1 = {0.f, 0.f, 0.f, 0.f};
    {
        const int r16 = F.lane & 15, h4 = F.lane >> 4;
        const bf16* xrow = hbuf + (size_t)(t0 + r16) * D_MODEL + 8 * h4;
        bf16x8 xf[32];
#pragma unroll
        for (int s = 0; s < 32; ++s) xf[s] = *(const bf16x8*)(xrow + 32 * s);
        __syncthreads();
        const LAS unsigned char* bh0 = wh + r16 * 2048; const LAS unsigned char* bh1 = wh + (16 + r16) * 2048;
        f32x4_r accq = {0.f, 0.f, 0.f, 0.f};
#pragma unroll
        for (int s = 0; s < 32; ++s) {
            const int chunk = 4 * s + h4, pc = ((chunk & ~15) | ((chunk & 15) ^ r16)) * 16;
            const bf16x8 wh0 = *(const LAS bf16x8*)(bh0 + pc), wh1 = *(const LAS bf16x8*)(bh1 + pc), wl0 = *(const LAS bf16x8*)(bh0 + 65536 + pc), wl1 = *(const LAS bf16x8*)(bh1 + 65536 + pc);
            acc0 = __builtin_amdgcn_mfma_f32_16x16x32_bf16(xf[s], wh0, acc0, 0, 0, 0); acc1 = __builtin_amdgcn_mfma_f32_16x16x32_bf16(xf[s], wh1, acc1, 0, 0, 0);
            acc0 = __builtin_amdgcn_mfma_f32_16x16x32_bf16(xf[s], wl0, acc0, 0, 0, 0); acc1 = __builtin_amdgcn_mfma_f32_16x16x32_bf16(xf[s], wl1, acc1, 0, 0, 0);
            accq = __builtin_amdgcn_mfma_f32_16x16x32_bf16(xf[s], xf[s], accq, 0, 0, 0);
            if ((s & 1) == 1) asm volatile("" ::: "memory");
        }
#pragma unroll
        for (int j2 = 0; j2 < 4; ++j2) if (r16 == 4 * h4 + j2) wst[256 + r16] = 1.f / sqrtf(accq[j2] * (1.f / D_MODEL) + NORM_EPS);
        LDS_WAIT(); asm volatile("" ::: "memory");
        const float rs = wst[256 + r16];
        unsigned char* xo = XN2 + (size_t)(t0 + r16) * D_MODEL + 8 * h4;
#pragma unroll
        for (int s = 0; s < 32; ++s) { const v4u w = __builtin_bit_cast(v4u, xf[s]); const f32x4 g0 = *(const LAS f32x4*)(gst + 32 * s + 8 * h4) * rs, g1 = *(const LAS f32x4*)(gst + 32 * s + 8 * h4 + 4) * rs;
            typedef unsigned u32x2_ __attribute__((ext_vector_type(2)));
            *(u32x2_*)(xo + 32 * s) = (u32x2_){pk4_fp8(bflo(w.x) * g0.x, bfhi(w.x) * g0.y, bflo(w.y) * g0.z, bfhi(w.y) * g0.w), pk4_fp8(bflo(w.z) * g1.x, bfhi(w.z) * g1.y, bflo(w.w) * g1.z, bfhi(w.w) * g1.w)}; if ((s & 3) == 3) asm volatile("" ::: "memory"); }
    }
    const float brl = b_router[F.lane >> 1];
#pragma unroll
    for (int half = 0; half < 2; ++half) {
        LDS_WAIT(); asm volatile("" ::: "memory");
        { const int r16 = F.lane & 15, h4 = F.lane >> 4;
          if ((h4 >> 1) == half) {
#pragma unroll
              for (int r = 0; r < 4; ++r) { const int tq = (h4 & 1) * 4 + r; const float rs = wst[256 + half * 8 + tq]; wst[tq * 32 + r16] = acc0[r] * rs; wst[tq * 32 + 16 + r16] = acc1[r] * rs; } } }
        LDS_WAIT(); asm volatile("" ::: "memory");
        for (int q = 0; q < 8; ++q) {
            float lg = wst[q * 32 + (F.lane >> 1)] + brl; int e = F.lane >> 1; asm volatile("" : "+v"(e)); int rank = 0;
#pragma unroll
            for (int j = 0; j < 32; ++j) { const float o = __builtin_bit_cast(float, __builtin_amdgcn_readlane(__builtin_bit_cast(int, lg), 2 * j)); rank += (o > lg || (o == lg && j < e)) ? 1 : 0; }
            const float mx = wave_sum((rank == 0 && (F.lane & 1) == 0) ? lg : 0.f);
            const bool sel = rank < 4 && (F.lane & 1) == 0;
            const float ex = sel ? __expf(lg - mx) : 0.f; const float den = wave_sum(ex);
            if (sel) { const int t = t0 + half * 8 + q; tope[t * 4 + rank] = e; topg[t * 4 + rank] = ex / den; __hip_atomic_fetch_add((LAS int*)hist + e, 1, __ATOMIC_RELAXED, __HIP_MEMORY_SCOPE_WORKGROUP); }
        }
    }
    __syncthreads();
    if (F.tid < 32) ((int*)(F.ws + WS_TAB + TAB_WGCNT))[F.vcu * 32 + F.tid] = hist[F.tid];
}

__device__ __forceinline__ void p7_scatter(Frame& F) {
    volatile LAS int* sh = (volatile LAS int*)(F.lds + RING_OFF);
    const int* wgc = (const int*)(F.ws + WS_TAB + TAB_WGCNT);
    { const int e = F.tid & 31, p = F.tid >> 5; int tot = 0, before = 0;
#pragma unroll
      for (int i = 0; i < 16; ++i) { const int w = 16 * p + i; const int c = wgc[w * 32 + e]; tot += c; before += (w < F.vcu) ? c : 0; }
      sh[256 + p * 32 + e] = tot; sh[768 + p * 32 + e] = before; }
    __syncthreads();
    if (F.tid < 32) { int tot = 0, before = 0;
#pragma unroll
        for (int p = 0; p < 16; ++p) { tot += sh[256 + p * 32 + F.tid]; before += sh[768 + p * 32 + F.tid]; }
        sh[F.tid] = tot; sh[32 + F.tid] = before; sh[64 + F.tid] = 0; }
    __syncthreads();
    if (F.tid == 0) { int s = 0; for (int e = 0; e < 32; ++e) { sh[96 + e] = s; s += sh[e]; } sh[128] = s; }
    __syncthreads();
    if (F.tid < 32) sh[32 + F.tid] += sh[96 + F.tid];
    if (F.vcu == 0 && F.tid < 32) {
        int* tiles = (int*)(F.ws + WS_TAB + TAB_TILES); const int e = F.tid; int nt = 0;
        for (int e2 = 0; e2 < e; ++e2) nt += (sh[e2] + 255) >> 8;
        const int cnt = sh[e], st = sh[96 + e];
        for (int i = 0; i * 256 < cnt; ++i) { *(v4u*)(tiles + 4 * (nt + i)) = (v4u){(unsigned)e, (unsigned)(st + 256 * i), (unsigned)((cnt - 256 * i) < 256 ? (cnt - 256 * i) : 256), 0u}; }
        if (e == 31) tiles[4 * MAX_TILES] = nt + ((cnt + 255) >> 8);
    }
    __syncthreads();
    const int* tope = (const int*)(F.ws + WS_TAB + TAB_TOPE); const float* topg = (const float*)(F.ws + WS_TAB + TAB_TOPG);
    int* slotof = (int*)(F.ws + WS_TAB + TAB_SLOTOF); int* slottok = (int*)(F.ws + WS_TAB + TAB_SLOTTOK); float* slotg = (float*)(F.ws + WS_TAB + TAB_SLOTG);
    { const int a = F.vcu * 512 + F.tid;
      const int e = tope[a]; const float gt = topg[a];
      const int pos = __hip_atomic_fetch_add((LAS int*)sh + 64 + e, 1, __ATOMIC_RELAXED, __HIP_MEMORY_SCOPE_WORKGROUP);
      const int slot = sh[32 + e] + pos;
      slotof[a] = slot; slottok[slot] = a >> 2; slotg[slot] = gt; }
}

__device__ __forceinline__ void p10_combine(Frame& F, const float* g_final, float* outp) {
    const int gw = F.vcu * NWAVES + F.wave, NGW = F.G * NWAVES;
    const int* slotof = (const int*)(F.ws + WS_TAB + TAB_SLOTOF);
    const unsigned char* Y1 = F.ws + WS_Y;
    f32x4 gg[4];
#pragma unroll
    for (int j = 0; j < 4; ++j) gg[j] = *((const f32x4*)g_final + F.lane + 64 * j);
    const int myslot = slotof[(gw + (F.lane >> 2) * NGW) * 4 + (F.lane & 3)];
    for (int k = 0; k < T_TOK / (NWAVES * 256); k += 2) {
        f32x4 v[2][4]; int sl[2][4];
#pragma unroll
        for (int q = 0; q < 2; ++q) { const int t = gw + (k + q) * NGW;
#pragma unroll
            for (int r = 0; r < 4; ++r) sl[q][r] = __shfl(myslot, (k + q) * 4 + r);
#pragma unroll
            for (int j = 0; j < 4; ++j) { typedef unsigned u32x2_ __attribute__((ext_vector_type(2))); const u32x2_ w = *((const u32x2_*)((const bf16*)(F.ws + WS_WD) + (size_t)t * D_MODEL) + F.lane + 64 * j);
                v[q][j] = (f32x4){bflo(w.x), bfhi(w.x), bflo(w.y), bfhi(w.y)}; } }
#pragma unroll
        for (int q = 0; q < 2; ++q)
#pragma unroll
            for (int r = 0; r < 4; ++r) { const unsigned char* yp = Y1 + (size_t)sl[q][r] * 1024;
#pragma unroll
                for (int j = 0; j < 4; ++j) { const int w = *((const int*)yp + F.lane + 64 * j); typedef float f2_ __attribute__((ext_vector_type(2)));
                    const f2_ lo = __builtin_amdgcn_cvt_pk_f32_fp8(w, false), hi = __builtin_amdgcn_cvt_pk_f32_fp8(w, true);
                    v[q][j].x += lo.x * YSCALE_INV; v[q][j].y += lo.y * YSCALE_INV; v[q][j].z += hi.x * YSCALE_INV; v[q][j].w += hi.y * YSCALE_INV; } }
#pragma unroll
        for (int q = 0; q < 2; ++q) { const int t = gw + (k + q) * NGW; float s = 0.f;
#pragma unroll
            for (int j = 0; j < 4; ++j) s += (v[q][j].x * v[q][j].x + v[q][j].y * v[q][j].y) + (v[q][j].z * v[q][j].z + v[q][j].w * v[q][j].w);
            const float rstd = 1.f / sqrtf(wave_sum(s) * (1.f / D_MODEL) + NORM_EPS);
#pragma unroll
            for (int j = 0; j < 4; ++j) *((f32x4*)(outp + (size_t)t * D_MODEL) + F.lane + 64 * j) = v[q][j] * rstd * gg[j]; }
    }
}
__device__ __forceinline__ rw::Bufs make_bufs(Frame& F) {
    rw::Bufs B; bf16* gu = (bf16*)(F.ws + WS_GU); bf16* wd = (bf16*)(F.ws + WS_WD); const size_t AS = (size_t)T_TOK * 512;
    B.KK = gu; B.BT = gu + AS; B.KT = gu + 2 * AS; B.RT = gu + 3 * AS; B.V = wd; B.G = wd + AS;
    B.McT = (bf16*)F.out; B.gamC = (float*)(F.ws + WS_RW); B.bonus = (float*)(F.ws + WS_TAB + TAB_BONUS);
    B.GcT = F.out; B.U0d = (unsigned*)((unsigned char*)F.out + 64 * MiB); B.S0 = (bf16*)((unsigned char*)F.out + 96 * MiB);
    return B;
}
__global__ void __launch_bounds__(NTHREADS, 2) fwd_kernel(Args args) {
    extern __shared__ __attribute__((aligned(16))) unsigned char lds[];
    Frame F;
    F.lds = (LAS unsigned char*)lds;
    F.MISC = (volatile LAS unsigned*)(F.lds + MISC_OFF);
    F.tid = threadIdx.x; F.lane = F.tid & 63; F.wave = __builtin_amdgcn_readfirstlane(F.tid >> 6);
    F.G = gridDim.x; { const int bx = blockIdx.x; F.vcu = (F.G % 8 == 0) ? (bx % 8) * (F.G / 8) + bx / 8 : bx; }
    F.ws = args.ws; F.out = args.out; F.ctl = (unsigned*)(args.ws + WS_CTL);
    for (int u = F.tid; u < (LDS_BYTES - LDSCTL_OFF) / 4; u += NTHREADS) ((LAS unsigned*)(F.lds + LDSCTL_OFF))[u] = 0u;
    __syncthreads();
#ifndef REPLAY_FROM
#define REPLAY_FROM -1
#endif
    int lo = args.ph_lo, hi = args.ph_hi & 255; const int pflags = args.ph_hi >> 8;
#if REPLAY_FROM > 6
    hi = 13;
#endif
    XcdBarrier bar; bar.bar = F.ctl + 4096; bar.x = 0; bar.st = nullptr;
    if (hi - lo > 1) bar = xcd_barrier_post(F.ctl + 4096, F.MISC + 8);
#ifndef REPMASK
#define REPMASK 0
#endif
#define IN(k) (lo <= (k) && (k) < hi)
#define REP(k) (((REPMASK >> (k)) & 1) != 0)
#define SEAM(k) do { if (IN(k) && IN((k) + 1)) xcd_barrier(bar); } while (0)
    const float* x = args.in[0];
    const int* tiles = (const int*)(F.ws + WS_TAB + TAB_TILES);
#ifndef REPBMASK
#define REPBMASK 0
#endif
#define REPB(k) (((REPBMASK >> (k)) & 1) != 0)
#define RUN(k, BODY) do { if (IN(k)) { BODY if (REP(k)) { __syncthreads(); BODY } if (REPB(k)) { xcd_barrier(bar); BODY } } } while (0)
#define B0 { p0_prologue(F, x, args.in[1], args.in[2], args.in[15]); p6_router_images(F, args.in[16], args.in[17]); }
#define B1 { pg8::Gemm g{(const pg8::bf16_t*)(F.ws + WS_BB), (const pg8::bf16_t*)(F.ws + WS_WIN), 1024, 2048}; pg8::DenseOrder S; S.init(T_TOK, INW_PAD, F.G, (int)blockIdx.x); \
        EpiProj E{(bf16*)(F.ws + WS_PROJ), INW_PAD}; pg8::gemm_phase<EpiProj, pg8::DenseOrder, false>(F.lds + RING_OFF, g, S, E); \
        if ((int)blockIdx.x >= (T_TOK / 256) * (INW_PAD / 256) - 6 * 256) {        \
            for (int it = F.wave; it < 32; it += NWAVES) conv_wdown_item(args.in[23], F.ws + WS_WDF, F.vcu * 32 + it, F.lane); if (F.tid == 0) F.MISC[23] = 1u; } }
#define B2 { p2_qkstats(F, F.ctl + 2048); const rw::Bufs B = make_bufs(F); p2_rwkv_prep2(F, args.in[4], args.in[5], args.in[6], args.in[7], args.in[8], args.in[9], args.in[10], args.in[11], args.in[12], B, REP(16) ? 2 : 1); }
#define CONV_GU_NEXT(itv) { int it_ = 0; if (F.lane == 0) it_ = (int)__hip_atomic_fetch_add((LAS unsigned*)(F.MISC + 20), 1u, __ATOMIC_RELAXED, __HIP_MEMORY_SCOPE_WORKGROUP); itv = __builtin_amdgcn_readfirstlane(it_); }
#define B3 { const rw::Bufs B = make_bufs(F); asm volatile("s_waitcnt vmcnt(0)" ::: "memory"); __syncthreads(); __builtin_amdgcn_fence(__ATOMIC_ACQUIRE, "agent"); asm volatile("s_waitcnt vmcnt(0)" ::: "memory"); \
        if (F.wave < 4) { if (!(pflags & 1)) { const int ub_ = (F.vcu >> 5) * 512 + (F.vcu & 31) * 2 + (F.wave & 1) + (F.wave >> 1) * 64; \
            for (int u = ub_; u < ub_ + 512; u += 128) { \
                if (REP(17)) rw::r1_chunk<true>(u, B, (rw::lds_ptr)(F.lds + RING_OFF + F.wave * 32768)); rw::r1_chunk<false>(u, B, (rw::lds_ptr)(F.lds + RING_OFF + F.wave * 32768)); } \
            } if (F.lane == 0) __hip_atomic_fetch_add((LAS unsigned*)(F.MISC + 21), 1u, __ATOMIC_RELAXED, __HIP_MEMORY_SCOPE_WORKGROUP); } \
        else if (!(pflags & 2)) { if (F.MISC[23] == 0u) { for (int it = (F.vcu * 4 + F.wave - 4) * 8; it < (F.vcu * 4 + F.wave - 4) * 8 + 8; ++it) conv_wdown_item(args.in[23], F.ws + WS_WDF, it, F.lane); } \
            for (;;) { if (F.MISC[21] >= 4u && !(pflags & 4)) break; int it; CONV_GU_NEXT(it) if (it >= 64) break; conv_gu_item(args.in[19], args.in[21], F.ws + WS_GUF, F.vcu * 64 + it, F.lane); } } }
#ifndef P4_SPLIT
#define P4_SPLIT 0
#endif
#ifndef R2_SHADOW_CONV
#define R2_SHADOW_CONV 0
#endif
#define B4A { if ((blockIdx.x & 1) == 0) { \
        { const int unit = (int)blockIdx.x >> 1; rw::r2_chain_wg(unit >> 1, unit & 1, B, (rw::lds_ptr)(F.lds + RING_OFF), F.wave); } \
        asm volatile("s_waitcnt vmcnt(0)" ::: "memory"); __syncthreads(); \
        if (F.tid == 0) { __builtin_amdgcn_fence(__ATOMIC_RELEASE, "agent"); asm volatile("s_waitcnt vmcnt(0)" ::: "memory"); (void)__hip_atomic_fetch_add(F.ctl + 2304, 1u, __ATOMIC_RELAXED, __HIP_MEMORY_SCOPE_AGENT); } } }
#define ATTN_ARGS F.MISC + 16, (const bf16*)(F.ws + WS_PROJ), (const float*)(F.ws + WS_TAB + TAB_KMEAN), F.ctl + 2048, args.in[3], (bf16*)(F.ws + WS_PROJ) + XR_OFF, (char*)lds + RING_OFF
#define R3_PULL(nmax) { if (F.wave < 4) { for (int n_ = 0; n_ < (nmax); ++n_) { int u = 0; if (F.lane == 0) u = (int)__hip_atomic_fetch_add(F.ctl + 2320, 1u, __ATOMIC_RELAXED, __HIP_MEMORY_SCOPE_AGENT); u = __builtin_amdgcn_readfirstlane(u); if (u >= BATCH * NH * 64) break; \
            rw::r3_chunk(u, B, args.in[13], args.in[14], (bf16*)(F.ws + WS_PROJ) + XR_OFF, (rw::lds_ptr)(F.lds + RING_OFF + F.wave * 32768)); } } }
#define B4 { const rw::Bufs B = make_bufs(F); B4A \
        bool r2seen_ = false; \
        for (;;) { const int more_ = att::attn_phase(F.ctl + 1024, ATTN_ARGS, 1); \
            if (!r2seen_) { if (F.tid == 0) F.MISC[24] = (__hip_atomic_load(F.ctl + 2304, __ATOMIC_RELAXED, __HIP_MEMORY_SCOPE_AGENT) >= 128u) ? 1u : 0u; __syncthreads(); \
                if (F.MISC[24] != 0u) { if (F.tid == 0) { __builtin_amdgcn_fence(__ATOMIC_ACQUIRE, "agent"); asm volatile("s_waitcnt vmcnt(0)" ::: "memory"); } __syncthreads(); r2seen_ = true; } } \
            if (!more_) break; \
            if (r2seen_) { __syncthreads(); R3_PULL(2) __syncthreads(); } } \
        if (!r2seen_) { if (F.tid == 0) { unsigned sp_ = 0; while (__hip_atomic_load(F.ctl + 2304, __ATOMIC_RELAXED, __HIP_MEMORY_SCOPE_AGENT) < 128u) { __builtin_amdgcn_s_sleep(2); if (++sp_ > (1u << 24)) break; } \
            __builtin_amdgcn_fence(__ATOMIC_ACQUIRE, "agent"); asm volatile("s_waitcnt vmcnt(0)" ::: "memory"); } } \
        __syncthreads(); }
#define B5 { const rw::Bufs B = make_bufs(F); \
        R3_PULL(1 << 20) \
        for (;;) { int it = 0; if (F.lane == 0) it = (int)__hip_atomic_fetch_add((LAS unsigned*)(F.MISC + 20), 1u, __ATOMIC_RELAXED, __HIP_MEMORY_SCOPE_WORKGROUP); it = __builtin_amdgcn_readfirstlane(it); if (it >= 64) break; \
            conv_gu_item(args.in[19], args.in[21], F.ws + WS_GUF, F.vcu * 64 + it, F.lane); } }
#define B6 { pg8::Gemm g{(const pg8::bf16_t*)(F.ws + WS_PROJ) + XR_OFF, (const pg8::bf16_t*)(F.ws + WS_WOUT), 1024, INW_PAD * 2}; pg8::DenseOrder S; S.init(T_TOK, 1024, F.G, (int)blockIdx.x); \
        EpiResid E{x, (bf16*)(F.ws + WS_WD)}; pg8::gemm_phase<EpiResid, pg8::DenseOrder, false>(F.lds + RING_OFF, g, S, E); }
#define B7 { }
#define B8 { p6_router(F, args.in[16], args.in[17], args.in[18]); }
#define B9 { p7_scatter(F); }
#define B10 { const int ntiles = __hip_atomic_load(tiles + 4 * MAX_TILES, RLX_AGENT); pg8::Gemm g{(const pg8::bf16_t*)F.out, (const pg8::bf16_t*)(F.ws + WS_GUF), 1024, 1024}; \
        MoeOrder S{tiles, 0, ntiles, 8, F.G, (int)blockIdx.x, (const int*)(F.ws + WS_TAB + TAB_SLOTTOK), 2048}; LAS unsigned short* btab = (LAS unsigned short*)(F.lds + LDSCTL_OFF + 6144); \
        { pg8::Unit tu; for (int i = 0; S.next(i, tu); ++i) { if (F.tid < 256) { const float* bsrc = (F.tid < 128 ? args.in[20] : args.in[22]) + (size_t)tu.e * 1024 + tu.ocol0 + (F.tid & 127); btab[i * 256 + F.tid] = (unsigned short)f2bf(*bsrc); } } __syncthreads(); } \
        EpiGlu E{F.ws + WS_H, btab}; pg8::gemm_phase<EpiGlu, MoeOrder, true, true>(F.lds + RING_OFF, g, S, E); }
#define B11 { const int ntiles = __hip_atomic_load(tiles + 4 * MAX_TILES, RLX_AGENT); \
        MoeOrder S{tiles, 0, ntiles, 4, F.G, (int)blockIdx.x, nullptr, 1024}; LAS float* gtab = (LAS float*)(F.lds + LDSCTL_OFF + 1024); \
        { pg8::Unit tu; const float* sg_ = (const float*)(F.ws + WS_TAB + TAB_SLOTG); for (int i = 0; S.next(i, tu); ++i) { if (F.tid < 256) gtab[i * 256 + F.tid] = (F.tid < tu.cnt) ? sg_[tu.orow0 + F.tid] : 0.f; } __syncthreads(); } \
        pg8::Gemm g{(const pg8::bf16_t*)(F.ws + WS_H), (const pg8::bf16_t*)(F.ws + WS_WDF), 1024, 1024}; EpiDown E{F.ws + WS_Y, args.in[24], gtab}; \
        pg8::gemm_phase<EpiDown, MoeOrder, false, true>(F.lds + RING_OFF, g, S, E); }
#define B12 { }
#define B13 { if (REP(18)) { p10_combine(F, args.in[25], (float*)(F.ws + WS_H + 112 * MiB)); __syncthreads(); } p10_combine(F, args.in[25], F.out); }
#define pass_ 0
    RUN(0, B0); SEAM(0); RUN(1, B1); SEAM(1); RUN(2, B2); RUN(3, B3); SEAM(3); RUN(4, B4); __syncthreads(); RUN(5, B5); SEAM(5); RUN(6, B6); RUN(7, B7); SEAM(7); RUN(8, B8); SEAM(8); RUN(9, B9); SEAM(9); RUN(10, B10); SEAM(10); RUN(11, B11); SEAM(12); RUN(13, B13);
#undef pass_
#if REPLAY_FROM >= 0
    xcd_barrier(bar); if (F.tid == 0) F.MISC[20] = 0u; __syncthreads(); lo = REPLAY_FROM; hi = 14;
#define pass_ 1
    RUN(0, B0); SEAM(0); RUN(1, B1); SEAM(1); RUN(2, B2); RUN(3, B3); SEAM(3); RUN(4, B4); __syncthreads(); RUN(5, B5); SEAM(5); RUN(6, B6); RUN(7, B7); SEAM(7); RUN(8, B8); SEAM(8); RUN(9, B9); SEAM(9); RUN(10, B10); SEAM(10); RUN(11, B11); SEAM(12); RUN(13, B13);
#undef pass_
#endif
#undef IN
#undef SEAM
}

extern "C" void kernel_launch(void* const* d_in, const int* in_sizes, int n_in, void* d_out, int out_size, void* d_ws, size_t ws_size, hipStream_t stream) {
    static int grid = 0;
    if (grid == 0) {
        if (n_in != 26 || out_size != T_TOK * D_MODEL || ws_size < WS_END) { fprintf(stderr, "kernel_launch: unexpected shapes n_in %d out %d ws %zu (need %zu)\n", n_in, out_size, ws_size, (size_t)WS_END); grid = -1; return; }
        int dev = 0, cus = 0;
        if (hipGetDevice(&dev) != hipSuccess || hipDeviceGetAttribute(&cus, hipDeviceAttributeMultiprocessorCount, dev) != hipSuccess) { grid = -1; return; }
        if (hipFuncSetAttribute((const void*)fwd_kernel, hipFuncAttributeMaxDynamicSharedMemorySize, LDS_BYTES) != hipSuccess) { fprintf(stderr, "kernel_launch: hipFuncSetAttribute failed\n"); grid = -1; return; }
        (void)hipGetLastError();
        grid = cus;
        if (grid != 256) { fprintf(stderr, "kernel_launch: %d CUs, need 256\n", grid); grid = -1; return; }
    }
    if (grid < 0) return;
    (void)hipMemsetAsync((char*)d_ws + WS_CTL, 0, CTL_ZERO_BYTES, stream);
    Args a{};
    for (int i = 0; i < 26; ++i) a.in[i] = (const float*)d_in[i];
    a.out = (float*)d_out; a.ws = (unsigned char*)d_ws;
#ifdef PREK
#ifndef PREFLAGS
#define PREFLAGS 0
#endif
    a.ph_lo = 0; a.ph_hi = PREK | (PREFLAGS << 8);
    hipLaunchKernelGGL(fwd_kernel, dim3(grid), dim3(NTHREADS), LDS_BYTES, stream, a);
    (void)hipMemsetAsync((char*)d_ws + WS_CTL, 0, CTL_ZERO_BYTES, stream);
#endif
    a.ph_lo = 0; a.ph_hi = 14;
    hipLaunchKernelGGL(fwd_kernel, dim3(grid), dim3(NTHREADS), LDS_BYTES, stream, a);
}
```

```cpp
#define REPMASK 0
#include <hip/hip_runtime.h>
#include <cstdio>
#include <cstdint>
namespace pg8 {
#define PG8_LAS __attribute__((address_space(3)))
typedef unsigned short bf16_t;
typedef short bf16x8 __attribute__((ext_vector_type(8)));
typedef float f32x4 __attribute__((ext_vector_type(4)));
typedef float f32x2 __attribute__((ext_vector_type(2)));
typedef unsigned u32x4 __attribute__((ext_vector_type(4)));
typedef unsigned u32x2 __attribute__((ext_vector_type(2)));
constexpr int BM = 256, BK = 64, HALF = 128, HTB = HALF * BK * 2, STAGE_BYTES = 8 * HTB, NXCD = 8, WGM = 8;

__host__ __device__ __forceinline__ int lds_byte(int r, int c) { const int st = (r >> 4) * 2 + (c >> 5), rr = r & 15, cc = c & 31, ob = rr * 64 + cc * 2; return st * 1024 + (ob ^ (((ob >> 9) & 1) << 5)); }
__host__ __device__ __forceinline__ void stage_rc(int b, int& R, int& C) { const int st = b / 1024, sb = b % 1024, swz = sb ^ (((sb >> 9) & 1) << 5); R = (st >> 1) * 16 + swz / 64; C = (st & 1) * 32 + (swz % 64) / 2; }
__host__ __device__ __forceinline__ int perm32(int rho) { const int n = rho >> 4, i = rho & 15; return 8 * (i >> 2) + 4 * n + (i & 3); }
typedef float f32x2c_t __attribute__((ext_vector_type(2))); typedef __bf16 bf16x2c_t __attribute__((ext_vector_type(2)));
__device__ __forceinline__ unsigned cvt_pk_bf16(float lo, float hi) { f32x2c_t v = {lo, hi}; bf16x2c_t b = __builtin_convertvector(v, bf16x2c_t); return __builtin_bit_cast(unsigned, b); }

__device__ __forceinline__ void glds4(const void* gsrc, unsigned lds_base) { unsigned keep;
    asm volatile("s_mov_b32 %0, m0\n\ts_mov_b32 m0, %2\n\ts_nop 0\n\tglobal_load_lds_dword %1, off\n\ts_mov_b32 m0, %0" : "=&s"(keep) : "v"(gsrc), "s"(lds_base) : "memory"); }

struct Unit { int arow0; int brow0; int orow0; int ocol0; int e; int cnt; const int* rows; int idx; };
struct Gemm { const bf16_t* A; const bf16_t* Bt; int K; int lda; };

struct DenseOrder {
    int nM, nN, nwg, G, c;
    __device__ void init(int M, int N, int G_, int c_) { nM = M / BM; nN = N / BM; nwg = nM * nN; G = G_; c = c_; }
    __device__ __forceinline__ bool next(int i, Unit& u) const {
        const long L = (long)i * G + c; if (L >= nwg) return false;
        int wgid = (int)L; { const int q = nwg / NXCD, r = nwg % NXCD, xcd = wgid % NXCD, off = wgid / NXCD; wgid = (xcd < r ? xcd * (q + 1) : r * (q + 1) + (xcd - r) * q) + off; }
        const int nig = WGM * nN, gid = wgid / nig, fm = gid * WGM, gsz = (nM - fm) < WGM ? (nM - fm) : WGM;
        const int pm = fm + ((wgid % nig) % gsz), pn = (wgid % nig) / gsz;
        u.arow0 = pm * BM; u.brow0 = pn * BM; u.orow0 = pm * BM; u.ocol0 = pn * BM; u.e = 0; u.cnt = BM; u.rows = nullptr; u.idx = i; return true;
    }
};

struct RowMajorOrder {
    int nwg, nN, G, c;
    __device__ __forceinline__ bool next(int i, Unit& u) const { const int L = i * G + c; if (L >= nwg) return false; const int pm = L / nN, pn = L - pm * nN;
        u.arow0 = pm * BM; u.brow0 = pn * BM; u.orow0 = pm * BM; u.ocol0 = pn * BM; u.e = 0; u.cnt = BM; u.rows = nullptr; u.idx = i; return true; }
};

template <class Epi, class Sched, bool GATHER, bool FP8 = false>
__device__ __forceinline__ void gemm_phase(PG8_LAS unsigned char* lds, const Gemm g, const Sched& S, const Epi& E) {
    const int tid = threadIdx.x, wid = __builtin_amdgcn_readfirstlane(tid >> 6), lane = tid & 63, wr = wid >> 2, wc = wid & 3, fr = lane & 15, fq = lane >> 4;
    const int KB = FP8 ? g.K : g.K * 2, nt = KB / (BK * 2);
    unsigned voffB[2];
    unsigned vA0[2], vA1[2];
#pragma unroll
    for (int i = 0; i < 2; ++i) { int R, C; stage_rc(tid * 16 + i * 8192, R, C); const int Rb = Epi::PERM ? ((R & ~31) + perm32(R & 31)) : R;
        voffB[i] = (unsigned)(Rb * KB + C * 2); }
    const size_t kstep = (size_t)(BK * 2);
    const size_t hstep = (size_t)HALF * KB;
    const unsigned ldsw = (unsigned)wid * 1024u;
    const int aoff = lds_byte(wr * 64 + fr, fq * 8), boff = lds_byte(wc * 32 + fr, fq * 8);
#define PG8_SA(b, h) (((b) * 2 + (h)) * HTB)
#define PG8_SB(b, h) ((4 + (b) * 2 + (h)) * HTB)
#define PG8_STAGE(bufoff, gbase, voff) do { _Pragma("unroll") for (int _i = 0; _i < 2; ++_i) \
        __builtin_amdgcn_global_load_lds((const unsigned*)((const char*)(gbase) + (voff)[_i]), (PG8_LAS unsigned*)(lds + (bufoff) + ldsw + _i * 8192), 16, 0, 0); } while (0)
#define PG8_LDA(dst, b, h) do { _Pragma("unroll") for (int m = 0; m < 4; ++m) _Pragma("unroll") for (int k = 0; k < 2; ++k) dst[m][k] = *(const PG8_LAS bf16x8*)(lds + PG8_SA(b, h) + aoff + m * 2048 + k * 1024); } while (0)
#define PG8_LDB(dst, b, h) do { _Pragma("unroll") for (int n = 0; n < 2; ++n) _Pragma("unroll") for (int k = 0; k < 2; ++k) dst[n][k] = *(const PG8_LAS bf16x8*)(lds + PG8_SB(b, h) + boff + n * 2048 + k * 1024); } while (0)
#define PG8_MMA(ai, bj, At, Bt) do { __builtin_amdgcn_s_setprio(1); _Pragma("unroll") for (int m = 0; m < 4; ++m) _Pragma("unroll") for (int n = 0; n < 2; ++n) { \
        if constexpr (FP8) { typedef int v8i_ __attribute__((ext_vector_type(8))); typedef int v4i_ __attribute__((ext_vector_type(4))); \
            const v4i_ b0_ = __builtin_bit_cast(v4i_, Bt[n][0]), b1_ = __builtin_bit_cast(v4i_, Bt[n][1]), a0_ = __builtin_bit_cast(v4i_, At[m][0]), a1_ = __builtin_bit_cast(v4i_, At[m][1]); \
            acc[ai][bj][m][n] = __builtin_amdgcn_mfma_scale_f32_16x16x128_f8f6f4((v8i_){b0_.x, b0_.y, b0_.z, b0_.w, b1_.x, b1_.y, b1_.z, b1_.w}, (v8i_){a0_.x, a0_.y, a0_.z, a0_.w, a1_.x, a1_.y, a1_.z, a1_.w}, acc[ai][bj][m][n], 0, 0, 0, 0x7f7f7f7f, 0, 0x7f7f7f7f); } \
        else { _Pragma("unroll") for (int k = 0; k < 2; ++k) acc[ai][bj][m][n] = __builtin_amdgcn_mfma_f32_16x16x32_bf16(Bt[n][k], At[m][k], acc[ai][bj][m][n], 0, 0, 0); } } \
        __builtin_amdgcn_s_setprio(0); } while (0)
#define PG8_WAIT_V(n) asm volatile("s_waitcnt vmcnt(" #n ")" ::: "memory")
#define PG8_WAIT_L(n) asm volatile("s_waitcnt lgkmcnt(" #n ")" ::: "memory")
#define PG8_BAR __builtin_amdgcn_s_barrier()
#define PG8_SCHED __builtin_amdgcn_sched_barrier(0)
#define PG8_LOADROWS(U, g0, g1) do { _Pragma("unroll") for (int _i = 0; _i < 2; ++_i) { int R_, C_; stage_rc(tid * 16 + _i * 8192, R_, C_); \
        if constexpr (GATHER) { g0[_i] = (R_ < (U).cnt) ? (U).rows[R_] : 0; g1[_i] = (R_ + HALF < (U).cnt) ? (U).rows[R_ + HALF] : 0; } \
        else { g0[_i] = (U).arow0 + R_; g1[_i] = (U).arow0 + R_ + HALF; } } } while (0)
#define PG8_SETA(g0, g1) do { _Pragma("unroll") for (int _i = 0; _i < 2; ++_i) { int R_, C_; stage_rc(tid * 16 + _i * 8192, R_, C_); \
        vA0[_i] = (unsigned)g0[_i] * (unsigned)g.lda + (unsigned)(C_ * 2); vA1[_i] = (unsigned)g1[_i] * (unsigned)g.lda + (unsigned)(C_ * 2); } } while (0)
    Unit cur, nxt; int ui = 0;
    if (!S.next(0, cur)) return;
    f32x4 acc[2][2][4][2];
#pragma unroll
    for (int a = 0; a < 2; ++a)
#pragma unroll
        for (int b = 0; b < 2; ++b)
#pragma unroll
            for (int m = 0; m < 4; ++m)
#pragma unroll
                for (int n = 0; n < 2; ++n) acc[a][b][m][n] = (f32x4){0.f, 0.f, 0.f, 0.f};
    bf16x8 At[4][2], B0[2][2], B1[2][2];
    const char* const Ab = (const char*)g.A;
    const char* cB = (const char*)g.Bt + (size_t)cur.brow0 * KB;
    { int g0[2], g1[2]; PG8_LOADROWS(cur, g0, g1); PG8_SETA(g0, g1); }
    PG8_STAGE(PG8_SB(0, 0), cB, voffB); PG8_STAGE(PG8_SB(0, 1), cB + hstep, voffB); PG8_STAGE(PG8_SA(0, 0), Ab, vA0); PG8_STAGE(PG8_SA(0, 1), Ab, vA1);
    if (wr == 1) PG8_BAR;
    PG8_WAIT_V(2); PG8_BAR;
    PG8_STAGE(PG8_SB(1, 0), cB + kstep, voffB); PG8_STAGE(PG8_SA(1, 0), Ab + kstep, vA0); PG8_STAGE(PG8_SB(1, 1), cB + hstep + kstep, voffB);
    PG8_WAIT_V(6); PG8_BAR;
    for (;;) {
        const bool has_next = S.next(ui + 1, nxt);
        const char* nB = has_next ? (const char*)g.Bt + (size_t)nxt.brow0 * KB : cB;
        for (int t = 0; t < nt; t += 2) {
            const bool last = (t == nt - 2);
            if constexpr (GATHER) { if (t == nt - 4 && has_next && wid < 4)
                glds4(nxt.rows + wid * 64 + lane, (unsigned)__builtin_amdgcn_readfirstlane((unsigned)(uintptr_t)(lds + STAGE_BYTES + 2048) + wid * 256)); }
            const char* a1 = Ab + (size_t)(t + 1) * kstep;
            const char* a2 = last ? Ab : Ab + (size_t)(t + 2) * kstep; const char* b2 = last ? nB : cB + (size_t)(t + 2) * kstep;
            const char* a3 = a2 + kstep; const char* b3 = b2 + kstep;
            PG8_LDB(B0, 0, 0); PG8_LDB(B1, 0, 1); PG8_SCHED; PG8_LDA(At, 0, 0); PG8_STAGE(PG8_SA(1, 1), a1, vA1);
            PG8_WAIT_V(8); PG8_WAIT_L(0); PG8_BAR; PG8_MMA(0, 0, At, B0); PG8_MMA(0, 1, At, B1); PG8_BAR; PG8_SCHED;
            if (last && has_next) {
                int g0[2], g1[2];
                if constexpr (GATHER) { int R0_, C0_; stage_rc(tid * 16, R0_, C0_); const PG8_LAS int* rl_ = (const PG8_LAS int*)(lds + STAGE_BYTES + 2048) + R0_;
                    const int a_ = rl_[0], b_ = rl_[64], c_ = rl_[128], d_ = rl_[192]; const int cn_ = nxt.cnt;
                    g0[0] = (R0_ < cn_) ? a_ : 0; g0[1] = (R0_ + 64 < cn_) ? b_ : 0; g1[0] = (R0_ + 128 < cn_) ? c_ : 0; g1[1] = (R0_ + 192 < cn_) ? d_ : 0; }
                else { PG8_LOADROWS(nxt, g0, g1); }
                PG8_SETA(g0, g1); }
            PG8_LDA(At, 0, 1); PG8_STAGE(PG8_SB(0, 0), b2, voffB); PG8_STAGE(PG8_SB(0, 1), b2 + hstep, voffB); PG8_STAGE(PG8_SA(0, 0), a2, vA0);
            PG8_WAIT_V(8); PG8_WAIT_L(0); PG8_BAR; PG8_MMA(1, 0, At, B0); PG8_MMA(1, 1, At, B1); PG8_BAR; PG8_SCHED;
            PG8_LDB(B0, 1, 0); PG8_LDB(B1, 1, 1); PG8_SCHED; PG8_LDA(At, 1, 0); PG8_STAGE(PG8_SA(0, 1), a2, vA1);
            PG8_WAIT_V(8); PG8_WAIT_L(0); PG8_BAR; PG8_MMA(0, 0, At, B0); PG8_MMA(0, 1, At, B1); PG8_BAR; PG8_SCHED;
            PG8_LDA(At, 1, 1); PG8_STAGE(PG8_SB(1, 0), b3, voffB); PG8_STAGE(PG8_SB(1, 1), b3 + hstep, voffB); PG8_STAGE(PG8_SA(1, 0), a3, vA0);
            PG8_WAIT_V(8); PG8_WAIT_L(0); PG8_BAR; PG8_MMA(1, 0, At, B0); PG8_MMA(1, 1, At, B1); PG8_BAR; PG8_SCHED;
        }
        if (wr == 0) PG8_BAR;
        E(acc, cur, wr, wc, fr, fq);
        if (!has_next) break;
#pragma unroll
        for (int a = 0; a < 2; ++a)
#pragma unroll
            for (int b = 0; b < 2; ++b)
#pragma unroll
                for (int m = 0; m < 4; ++m)
#pragma unroll
                    for (int n = 0; n < 2; ++n) acc[a][b][m][n] = (f32x4){0.f, 0.f, 0.f, 0.f};
        cur = nxt; cB = nB; ++ui;
        if (wr == 1) PG8_BAR;
    }
    PG8_WAIT_V(0);
    PG8_BAR;
#undef PG8_SA
#undef PG8_SB
#undef PG8_STAGE
#undef PG8_LDA
#undef PG8_LDB
#undef PG8_MMA
#undef PG8_WAIT_V
#undef PG8_WAIT_L
#undef PG8_BAR
#undef PG8_SCHED
#undef PG8_SETA
#undef PG8_LOADROWS
}
}
constexpr int D_MODEL = 1024, BATCH = 8, SEQ = 4096, T_TOK = BATCH * SEQ;
constexpr int HD = 64, NH = 8, ATTN_W = 512, RWKV_W = 512;
constexpr int LORA_W = 32, LORA_A = 32, LORA_G = 96;
constexpr int XR_W = 3 * RWKV_W + LORA_W + LORA_A + LORA_G;
constexpr int INW = 3 * ATTN_W + XR_W;
constexpr int INW_PAD = 3328;
constexpr int XR_OFF = 3 * ATTN_W;
constexpr int NEXP = 32, TOPK = 4, NASSIGN = T_TOK * TOPK;
constexpr int MAX_TILES = NASSIGN / 256 + NEXP;
constexpr float NORM_EPS = 1e-6f;
constexpr float DECAY_SCALE = 0.6065306597126334f;
constexpr float GN_EPS = 64e-5f;
constexpr int NWAVES = 8, NTHREADS = 512;

#define GAS __attribute__((address_space(1)))
#define LAS __attribute__((address_space(3)))
typedef unsigned short bf16;
typedef unsigned v4u __attribute__((ext_vector_type(4)));
typedef unsigned v2u __attribute__((ext_vector_type(2)));
typedef float f32x4 __attribute__((ext_vector_type(4)));
typedef float f32x2 __attribute__((ext_vector_type(2)));
typedef short bf16x8 __attribute__((ext_vector_type(8)));
#define RLX_AGENT __ATOMIC_RELAXED, __HIP_MEMORY_SCOPE_AGENT
#define LDS_WAIT() asm volatile("s_waitcnt lgkmcnt(0)" ::: "memory")
#define VM_WAIT() asm volatile("s_waitcnt vmcnt(0)" ::: "memory")
__device__ __forceinline__ unsigned f2bf(float f) { unsigned u = __builtin_bit_cast(unsigned, f); return (u + 0x7fffu + ((u >> 16) & 1u)) >> 16; }
__device__ __forceinline__ unsigned pk2(float lo, float hi) { return f2bf(lo) | (f2bf(hi) << 16); }
__device__ __forceinline__ float bf2f(unsigned short b) { return __builtin_bit_cast(float, ((unsigned)b) << 16); }
__device__ __forceinline__ float bflo(unsigned w) { return __builtin_bit_cast(float, w << 16); }
__device__ __forceinline__ float bfhi(unsigned w) { return __builtin_bit_cast(float, w & 0xffff0000u); }
__device__ __forceinline__ float wave_sum(float v) {
#pragma unroll
    for (int o = 1; o < 64; o <<= 1) v += __shfl_xor(v, o);
    return v;
}
__device__ __forceinline__ float wave_sum_dpp(float v) {
    v += __builtin_bit_cast(float, __builtin_amdgcn_update_dpp(0, __builtin_bit_cast(int, v), 0xB1, 0xf, 0xf, false));
    v += __builtin_bit_cast(float, __builtin_amdgcn_update_dpp(0, __builtin_bit_cast(int, v), 0x4E, 0xf, 0xf, false));
    v += __builtin_bit_cast(float, __builtin_amdgcn_update_dpp(0, __builtin_bit_cast(int, v), 0x141, 0xf, 0xf, false));
    v += __builtin_bit_cast(float, __builtin_amdgcn_update_dpp(0, __builtin_bit_cast(int, v), 0x140, 0xf, 0xf, false));
    const int vi = __builtin_bit_cast(int, v);
    return (__builtin_bit_cast(float, __builtin_amdgcn_readlane(vi, 0)) + __builtin_bit_cast(float, __builtin_amdgcn_readlane(vi, 16))) + (__builtin_bit_cast(float, __builtin_amdgcn_readlane(vi, 32)) + __builtin_bit_cast(float, __builtin_amdgcn_readlane(vi, 48)));
}
__device__ __forceinline__ float sigmoidf_(float x) { return 1.0f / (1.0f + __expf(-x)); }

constexpr size_t MiB = 1u << 20;
constexpr size_t WS_CTL = 0, CTL_ZERO_BYTES = 64 * 1024;
constexpr size_t WS_TAB = 1 * MiB;
constexpr size_t TAB_TOPE = 0;
constexpr size_t TAB_TOPG = TAB_TOPE + (size_t)NASSIGN * 4;
constexpr size_t TAB_SLOTOF = TAB_TOPG + (size_t)NASSIGN * 4;
constexpr size_t TAB_SLOTTOK = TAB_SLOTOF + (size_t)NASSIGN * 4;
constexpr size_t TAB_SLOTG = TAB_SLOTTOK + (size_t)(NASSIGN + 256) * 4;
constexpr size_t TAB_WGCNT = TAB_SLOTG + (size_t)(NASSIGN + 256) * 4;
constexpr size_t TAB_TILES = TAB_WGCNT + 256 * 32 * 4;
constexpr size_t TAB_KMEAN = TAB_TILES + (size_t)(MAX_TILES + 1) * 16;
constexpr size_t TAB_BONUS = TAB_KMEAN + (size_t)BATCH * NH * 16 * 64 * 4;
constexpr size_t TAB_END = TAB_BONUS + (size_t)T_TOK * 8 * 4;
static_assert(TAB_END <= 5 * MiB, "tables");
constexpr size_t WS_GU = 6 * MiB;
constexpr size_t WS_BB = WS_GU + 128 * MiB;
constexpr size_t WS_WD = WS_BB + 64 * MiB;
constexpr size_t WS_R3 = WS_WD + 64 * MiB;
constexpr size_t WS_PROJ = WS_R3;
constexpr size_t WS_WIN = WS_PROJ + (size_t)T_TOK * INW_PAD * 2;
constexpr size_t WS_WOUT = WS_WIN + (size_t)INW_PAD * 1024 * 2;
constexpr size_t WS_RW = WS_WOUT + (size_t)1024 * 1024 * 2;
constexpr size_t WS_H = WS_R3;
constexpr size_t WS_GUF = WS_BB;
constexpr size_t WS_WDF = WS_R3 + 225 * MiB;
constexpr size_t WS_ROUT = WS_R3 + 218 * MiB;
constexpr size_t WS_Y = WS_GU;
constexpr size_t WS_END = WS_R3 + 257 * MiB;
constexpr int Y_SPLIT_TILES = 320, Y_SPLIT_ROWS = Y_SPLIT_TILES * 256;
static_assert(WS_END <= 520 * MiB, "ws map");
#define XB_TMO      128
#define XB_XCNT(j)  (256  + 64 * (j))
#define XB_XSUB(j)  (1280 + 64 * (j))
#define XB_XGEN(j)  (2304 + 64 * (j))
#define XB_TOP      3328
#define XB_TOPGEN   3392
#define XCD_BAR_WORDS 3456
#define XB_SPIN_CAP (1u << 22)
__device__ __forceinline__ unsigned xb_ld(unsigned* p)              { return __hip_atomic_load(p, __ATOMIC_RELAXED, __HIP_MEMORY_SCOPE_AGENT); }
__device__ __forceinline__ unsigned xb_add(unsigned* p, unsigned v) { return __hip_atomic_fetch_add(p, v, __ATOMIC_RELAXED, __HIP_MEMORY_SCOPE_AGENT); }
__device__ __forceinline__ unsigned xb_xcc_id() { return (unsigned)__builtin_amdgcn_s_getreg((3 << 11) | 20) & 0xFu; }
#define XB_SPIN(cond, bar) do { unsigned _sp = 0; while (cond) { __builtin_amdgcn_s_sleep(1); \
    if ((++_sp & 255u) == 0u) { if (xb_ld(&(bar)[XB_TMO])) break; if (_sp > XB_SPIN_CAP) { atomicAdd(&(bar)[XB_TMO], 1u); break; } } } } while (0)
struct XcdBarrier { unsigned* bar; unsigned x; volatile LAS unsigned* st; };
__device__ __forceinline__ XcdBarrier xcd_barrier_post(unsigned* bar, volatile LAS unsigned* st) {
    XcdBarrier b; b.bar = bar; b.x = xb_xcc_id(); b.st = st;
    if (threadIdx.x == 0) (void)xb_add(&bar[XB_XCNT(b.x)], 1u);
    return b;
}
__device__ __forceinline__ void xcd_barrier_complete(unsigned* bar, unsigned x, unsigned& nloc, unsigned& nx) {
    const unsigned G = gridDim.x * gridDim.y * gridDim.z;
    unsigned sum, cnt, mine, sp = 0u;
    for (;;) {
        sum = 0u; cnt = 0u; mine = 0u;
#pragma unroll
        for (unsigned j = 0; j < 16; ++j) { const unsigned c = xb_ld(&bar[XB_XCNT(j)]); sum += c; cnt += (c > 0u) ? 1u : 0u; mine = (j == x) ? c : mine; }
        if (sum == G) break;
        __builtin_amdgcn_s_sleep(1);
        if ((++sp & 255u) == 0u) { if (xb_ld(&bar[XB_TMO])) break; if (sp > XB_SPIN_CAP) { atomicAdd(&bar[XB_TMO], 1u); break; } }
    }
    nloc = mine > 0u ? mine : 1u; nx = cnt > 0u ? cnt : 1u;
}
__device__ __forceinline__ void xcd_barrier(const XcdBarrier& b) {
    asm volatile("s_waitcnt vmcnt(0)" ::: "memory");
    __syncthreads();
    if (threadIdx.x == 0) {
        unsigned* bar = b.bar;
        __builtin_amdgcn_s_waitcnt(0);
        unsigned nloc = b.st[0], nx = b.st[1];
        if (nloc == 0u) { xcd_barrier_complete(bar, b.x, nloc, nx); b.st[0] = nloc; b.st[1] = nx; }
        const unsigned old = xb_add(&bar[XB_XSUB(b.x)], 1u);
        const unsigned gen = old / nloc;
        if (old + 1u == (gen + 1u) * nloc) {
            __builtin_amdgcn_fence(__ATOMIC_RELEASE, "agent");
            asm volatile("s_waitcnt vmcnt(0)" ::: "memory");
            const unsigned og = xb_add(&bar[XB_TOP], 1u);
            const unsigned tg = og / nx;
            if (og + 1u == (tg + 1u) * nx) xb_add(&bar[XB_TOPGEN], 1u);
            else XB_SPIN(xb_ld(&bar[XB_TOPGEN]) == tg, bar);
            __builtin_amdgcn_fence(__ATOMIC_ACQUIRE, "agent");
            xb_add(&bar[XB_XGEN(b.x)], 1u);
            asm volatile("s_waitcnt vmcnt(0)" ::: "memory");
        } else {
            XB_SPIN(xb_ld(&bar[XB_XGEN(b.x)]) == gen, bar);
            __builtin_amdgcn_fence(__ATOMIC_ACQUIRE, "agent");
            asm volatile("s_waitcnt vmcnt(0)" ::: "memory");
        }
    }
    __syncthreads();
}

constexpr int RING_OFF = 0, RING_BYTES = 131072;
constexpr int LDSCTL_OFF = RING_BYTES, MISC_OFF = LDSCTL_OFF + 320;
constexpr int LDS_BYTES = 147456;

struct Args { const float* in[26]; float* out; unsigned char* ws; int ph_lo, ph_hi; };
struct Frame {
    LAS unsigned char* lds;
    volatile LAS unsigned* MISC;
    unsigned* ctl;
    int tid, lane, wave;
    int vcu, G;
    unsigned char* ws;
    float* out;
};
__device__ __forceinline__ void p0_transpose_item(const float* W, int N, bf16* WT, int KT, int k0, int n0, int drow0, LAS float* scr, int lane) {
    float t_[32];
#pragma unroll
    for (int i = 0; i < 32; ++i) { const int kk = 2 * i + (lane >> 5); t_[i] = __builtin_nontemporal_load(W + (size_t)(k0 + kk) * N + n0 + (lane & 31)); }
#pragma unroll
    for (int i = 0; i < 32; ++i) { const int kk = 2 * i + (lane >> 5); scr[kk * 33 + (lane & 31)] = t_[i]; }
    LDS_WAIT(); asm volatile("" ::: "memory");
    const int c = lane & 7;
#pragma unroll
    for (int j = 0; j < 4; ++j) { const int n = (lane >> 3) + 8 * j; const LAS float* s = scr + (8 * c) * 33 + n;
        v4u o; o.x = pk2(s[0 * 33], s[1 * 33]); o.y = pk2(s[2 * 33], s[3 * 33]); o.z = pk2(s[4 * 33], s[5 * 33]); o.w = pk2(s[6 * 33], s[7 * 33]);
        *(GAS v4u*)(WT + (size_t)(drow0 + n) * KT + k0 + 8 * c) = o; }
    LDS_WAIT(); asm volatile("" ::: "memory");
}
__device__ __forceinline__ unsigned pk4_fp8(float a, float b, float c, float d) { int w = 0; w = __builtin_amdgcn_cvt_pk_fp8_f32(a, b, w, false); w = __builtin_amdgcn_cvt_pk_fp8_f32(c, d, w, true); return (unsigned)w; }
constexpr float WSCALE = 32.0f, WSCALE_INV = 1.0f / 32.0f;
constexpr float YSCALE = 16.0f, YSCALE_INV = 1.0f / 16.0f;
__device__ __forceinline__ void p0_transpose_item_fp8(const float* W, int N, unsigned char* WT, int KT, int k0, int n0, int drow0, LAS float* scr, int lane) {
#pragma unroll 8
    for (int i = 0; i < 32; ++i) { const int kk = 2 * i + (lane >> 5); scr[kk * 33 + (lane & 31)] = __builtin_nontemporal_load(W + (size_t)(k0 + kk) * N + n0 + (lane & 31)); }
    LDS_WAIT(); asm volatile("" ::: "memory");
    const int n = lane >> 1, hf = lane & 1; const LAS float* s = scr + (32 * hf) * 33 + n;
    unsigned w[8];
#pragma unroll
    for (int q = 0; q < 8; ++q) w[q] = pk4_fp8(s[(4 * q) * 33] * WSCALE, s[(4 * q + 1) * 33] * WSCALE, s[(4 * q + 2) * 33] * WSCALE, s[(4 * q + 3) * 33] * WSCALE);
    GAS v4u* dst = (GAS v4u*)(WT + (size_t)(drow0 + n) * KT + k0 + 32 * hf);
    dst[0] = (v4u){w[0], w[1], w[2], w[3]}; dst[1] = (v4u){w[4], w[5], w[6], w[7]};
    LDS_WAIT(); asm volatile("" ::: "memory");
}
__device__ __forceinline__ void conv_item_fp8(const float* W, unsigned char* WT, int k0, int n0, int drow0, int lane) {
    const int kq = lane >> 4, nq = lane & 15;
    const float* src = W + (size_t)(k0 + 16 * kq) * 1024 + n0 + 4 * nq; f32x4 v[16];
#pragma unroll
    for (int i = 0; i < 16; ++i) v[i] = __builtin_nontemporal_load((const f32x4*)(src + (size_t)i * 1024)) * WSCALE;
    unsigned char* dst = WT + (size_t)(drow0 + 4 * nq) * 1024 + k0 + 16 * kq;
#pragma unroll
    for (int j = 0; j < 4; ++j) __builtin_nontemporal_store((v4u){pk4_fp8(v[0][j], v[1][j], v[2][j], v[3][j]), pk4_fp8(v[4][j], v[5][j], v[6][j], v[7][j]), pk4_fp8(v[8][j], v[9][j], v[10][j], v[11][j]), pk4_fp8(v[12][j], v[13][j], v[14][j], v[15][j])}, (v4u*)(dst + (size_t)j * 1024));
}
__device__ __forceinline__ void conv_wdown_item(const float* wd, unsigned char* WDF, int it, int lane) {
    const int e = it >> 8, kb = (it >> 4) & 15, nb = it & 15; conv_item_fp8(wd + (size_t)e * 1048576, WDF, 64 * kb, 64 * nb, e * 1024 + 64 * nb, lane); }
__device__ __forceinline__ void conv_gu_item(const float* wg, const float* wu, unsigned char* GUF, int it, int lane) {
    const int which = it >> 13, e = (it >> 8) & 31, kb = (it >> 4) & 15, nb = it & 15, n0 = 64 * nb;
    conv_item_fp8((which ? wu : wg) + (size_t)e * 1048576, GUF, 64 * kb, n0, e * 2048 + 256 * (n0 >> 7) + 128 * which + (n0 & 127), lane); }
__device__ __forceinline__ void rms_row_to_bf16(const float* xrow, const float* g, bf16* orow, int lane) {
    const GAS f32x4* xr = (const GAS f32x4*)xrow + lane; const GAS f32x4* gr = (const GAS f32x4*)g + lane;
    f32x4 v[4]; float s = 0.f;
#pragma unroll
    for (int j = 0; j < 4; ++j) { v[j] = xr[64 * j]; s += (v[j].x * v[j].x + v[j].y * v[j].y) + (v[j].z * v[j].z + v[j].w * v[j].w); }
    const float rstd = 1.f / sqrtf(wave_sum(s) * (1.f / D_MODEL) + NORM_EPS);
    GAS unsigned long long* o8 = (GAS unsigned long long*)orow + lane;
#pragma unroll
    for (int j = 0; j < 4; ++j) { const f32x4 gg = gr[64 * j];
        o8[64 * j] = (unsigned long long)pk2(v[j].x * rstd * gg.x, v[j].y * rstd * gg.y) | ((unsigned long long)pk2(v[j].z * rstd * gg.z, v[j].w * rstd * gg.w) << 32); }
}
__device__ __forceinline__ void p0_prologue(Frame& F, const float* x, const float* g_mix, const float* w_in, const float* w_out) {
    LAS float* scr = (LAS float*)(F.lds + RING_OFF + F.wave * 16384);
    const int gw = F.vcu * NWAVES + F.wave, NGW = F.G * NWAVES;
    bf16* WIN = (bf16*)(F.ws + WS_WIN); bf16* WOUT = (bf16*)(F.ws + WS_WOUT); bf16* XN = (bf16*)(F.ws + WS_BB);
    constexpr int I_IN = 16 * (INW / 32), I_OUT = 16 * 32;
    for (int it = gw; it < I_IN + I_OUT; it += NGW) {
        if (it < I_IN) { const int kb = it / (INW / 32), nb = it % (INW / 32); p0_transpose_item(w_in, INW, WIN, 1024, 64 * kb, 32 * nb, 32 * nb, scr, F.lane); }
        else { const int r = it - I_IN, kb = r / 32, nb = r % 32; p0_transpose_item(w_out, 1024, WOUT, 1024, 64 * kb, 32 * nb, 32 * nb, scr, F.lane); }
    }
    for (int i = gw * 64 + F.lane; i < (INW_PAD - INW) * 1024 / 8; i += NGW * 64) ((GAS v4u*)(WIN + (size_t)INW * 1024))[i] = (v4u){0u, 0u, 0u, 0u};
    {
        const GAS f32x4* gr = (const GAS f32x4*)g_mix + F.lane; f32x4 gg[4];
#pragma unroll
        for (int j = 0; j < 4; ++j) gg[j] = gr[64 * j];
        for (int m0 = gw; m0 < T_TOK; m0 += 4 * NGW) {
            f32x4 v[4][4]; float sq[4];
#pragma unroll
            for (int u = 0; u < 4; ++u)
#pragma unroll
                for (int j = 0; j < 4; ++j) v[u][j] = __builtin_nontemporal_load((const f32x4*)(x + (size_t)(m0 + u * NGW) * D_MODEL) + F.lane + 64 * j);
#pragma unroll
            for (int u = 0; u < 4; ++u) { float a = 0.f;
#pragma unroll
                for (int j = 0; j < 4; ++j) a += (v[u][j].x * v[u][j].x + v[u][j].y * v[u][j].y) + (v[u][j].z * v[u][j].z + v[u][j].w * v[u][j].w);
                sq[u] = a; }
#pragma unroll
            for (int u = 0; u < 4; ++u) { const float rstd = 1.f / sqrtf(wave_sum(sq[u]) * (1.f / D_MODEL) + NORM_EPS);
                GAS unsigned long long* o8 = (GAS unsigned long long*)(XN + (size_t)(m0 + u * NGW) * D_MODEL) + F.lane;
#pragma unroll
                for (int j = 0; j < 4; ++j) o8[64 * j] = (unsigned long long)pk2(v[u][j].x * rstd * gg[j].x, v[u][j].y * rstd * gg[j].y) | ((unsigned long long)pk2(v[u][j].z * rstd * gg[j].z, v[u][j].w * rstd * gg[j].w) << 32); }
        }
    }
}
__device__ __forceinline__ void p0_moe_weights(Frame& F, const float* wg, const float* wu, const float* wd) {
    LAS float* scr = (LAS float*)(F.lds + RING_OFF + F.wave * 16384);
    const int gw = F.vcu * NWAVES + F.wave, NGW = F.G * NWAVES;
    unsigned char* GU = F.ws + WS_GU; unsigned char* WD = F.ws + WS_WD;
    constexpr int IPE = 16 * 32;
    for (int it = gw; it < NEXP * 3 * IPE; it += NGW) {
        const int e = it / (3 * IPE), r = it % (3 * IPE), which = r / IPE, q = r % IPE, kb = q / 32, nb = q % 32, n0 = 32 * nb;
        if (which == 0) p0_transpose_item_fp8(wg + (size_t)e * 1048576, 1024, GU, 1024, 64 * kb, n0, e * 2048 + 256 * (n0 >> 7) + (n0 & 127), scr, F.lane);
        else if (which == 1) p0_transpose_item_fp8(wu + (size_t)e * 1048576, 1024, GU, 1024, 64 * kb, n0, e * 2048 + 256 * (n0 >> 7) + 128 + (n0 & 127), scr, F.lane);
        else p0_transpose_item_fp8(wd + (size_t)e * 1048576, 1024, WD, 1024, 64 * kb, n0, e * 1024 + n0, scr, F.lane);
    }
}

struct EpiProj {
    static constexpr bool PERM = true;
    bf16* O; int ldc;
    __device__ __forceinline__ void operator()(const f32x4 (&acc)[2][2][4][2], const pg8::Unit& u, int wr, int wc, int fr, int fq) const {
        const int row0 = u.orow0 + wr * 64 + fr, col0 = u.ocol0 + wc * 32 + 8 * fq;
#pragma unroll
        for (int ai = 0; ai < 2; ++ai)
#pragma unroll
            for (int m = 0; m < 4; ++m) { bf16* rowp = O + (size_t)(row0 + ai * 128 + m * 16) * ldc + col0;
#pragma unroll
                for (int bj = 0; bj < 2; ++bj) { const f32x4 v0 = acc[ai][bj][m][0], v1 = acc[ai][bj][m][1];
                    v4u w; w.x = pg8::cvt_pk_bf16(v0[0], v0[1]); w.y = pg8::cvt_pk_bf16(v0[2], v0[3]); w.z = pg8::cvt_pk_bf16(v1[0], v1[1]); w.w = pg8::cvt_pk_bf16(v1[2], v1[3]);
                    *(v4u*)(rowp + bj * 128) = w; } }
    }
};
struct EpiResid {
    static constexpr bool PERM = true;
    const float* base; bf16* out;
    __device__ __forceinline__ void operator()(const f32x4 (&acc)[2][2][4][2], const pg8::Unit& u, int wr, int wc, int fr, int fq) const {
        const int row0 = u.orow0 + wr * 64 + fr, col0 = u.ocol0 + wc * 32 + 8 * fq;
        f32x4 xb[2][2][2];
#define ER_LOAD(buf_, it_) do { const size_t off_ = (size_t)(row0 + ((it_) >> 2) * 128 + ((it_) & 3) * 16) * D_MODEL + col0; \
            xb[buf_][0][0] = *(const f32x4*)(base + off_); xb[buf_][0][1] = *(const f32x4*)(base + off_ + 4); xb[buf_][1][0] = *(const f32x4*)(base + off_ + 128); xb[buf_][1][1] = *(const f32x4*)(base + off_ + 132); } while (0)
        ER_LOAD(0, 0);
#pragma unroll
        for (int it = 0; it < 8; ++it) { const int ai = it >> 2, m = it & 3, cb = it & 1; const size_t off = (size_t)(row0 + ai * 128 + m * 16) * D_MODEL + col0;
            if (it + 1 < 8) ER_LOAD(cb ^ 1, it + 1);
#pragma unroll
            for (int bj = 0; bj < 2; ++bj) { const f32x4 v0 = xb[cb][bj][0] + acc[ai][bj][m][0], v1 = xb[cb][bj][1] + acc[ai][bj][m][1];
                v4u w; w.x = pg8::cvt_pk_bf16(v0[0], v0[1]); w.y = pg8::cvt_pk_bf16(v0[2], v0[3]); w.z = pg8::cvt_pk_bf16(v1[0], v1[1]); w.w = pg8::cvt_pk_bf16(v1[2], v1[3]);
                *(v4u*)(out + off + bj * 128) = w; }
            asm volatile("" ::: "memory"); }
#undef ER_LOAD
    }
};
struct EpiGlu {
    static constexpr bool PERM = true;
    unsigned char* H; const LAS unsigned short* btab;
    __device__ __forceinline__ void operator()(const f32x4 (&acc)[2][2][4][2], const pg8::Unit& u, int wr, int wc, int fr, int fq) const {
        const int lrow0 = wr * 64 + fr, cl = wc * 32 + 8 * fq, col0 = u.ocol0 + cl;
        const v4u gw = *(const LAS v4u*)(btab + u.idx * 256 + cl), uw = *(const LAS v4u*)(btab + u.idx * 256 + 128 + cl);
        const f32x4 gb0 = {bflo(gw.x), bfhi(gw.x), bflo(gw.y), bfhi(gw.y)}, gb1 = {bflo(gw.z), bfhi(gw.z), bflo(gw.w), bfhi(gw.w)};
        const f32x4 ub0 = {bflo(uw.x), bfhi(uw.x), bflo(uw.y), bfhi(uw.y)}, ub1 = {bflo(uw.z), bfhi(uw.z), bflo(uw.w), bfhi(uw.w)};
#pragma unroll
        for (int ai = 0; ai < 2; ++ai)
#pragma unroll
            for (int m = 0; m < 4; ++m) { const int lr = lrow0 + ai * 128 + m * 16; unsigned w[2];
#pragma unroll
                for (int n = 0; n < 2; ++n) { const f32x4 gv = acc[ai][0][m][n] * WSCALE_INV + (n ? gb1 : gb0), uv = acc[ai][1][m][n] * WSCALE_INV + (n ? ub1 : ub0);
                    const f32x4 ga = __builtin_elementwise_min(gv, (f32x4){7.0f, 7.0f, 7.0f, 7.0f}), up = __builtin_elementwise_min(__builtin_elementwise_max(uv, (f32x4){-7.0f, -7.0f, -7.0f, -7.0f}), (f32x4){7.0f, 7.0f, 7.0f, 7.0f});
                    const f32x4 tq = ga * (-1.702f * 1.4426950408889634f);
                    const f32x4 dq = (f32x4){__builtin_amdgcn_exp2f(tq[0]), __builtin_amdgcn_exp2f(tq[1]), __builtin_amdgcn_exp2f(tq[2]), __builtin_amdgcn_exp2f(tq[3])} + 1.0f;
                    const f32x4 glu = ga * (f32x4){__builtin_amdgcn_rcpf(dq[0]), __builtin_amdgcn_rcpf(dq[1]), __builtin_amdgcn_rcpf(dq[2]), __builtin_amdgcn_rcpf(dq[3])};
                    const f32x4 hv = __builtin_elementwise_fma(up, glu, glu);
                    w[n] = pk4_fp8(hv[0], hv[1], hv[2], hv[3]); }
                if (lr < u.cnt) *(v2u*)(H + (size_t)(u.orow0 + lr) * 1024 + col0) = (v2u){w[0], w[1]};
                asm volatile("" ::: "memory"); }
    }
};
struct EpiDown {
    static constexpr bool PERM = true;
    unsigned char* Y1; const LAS unsigned short* bdtab; const LAS float* gtab;
    __device__ __forceinline__ void operator()(const f32x4 (&acc)[2][2][4][2], const pg8::Unit& u, int wr, int wc, int fr, int fq) const {
        const int lrow0 = wr * 64 + fr, cl = wc * 32 + 8 * fq, col0 = u.ocol0 + cl;
#pragma unroll
        for (int bj = 0; bj < 2; ++bj) {
            const v4u bw = *(const LAS v4u*)(bdtab + u.idx * 256 + bj * 128 + cl);
            const f32x4 b0 = {bflo(bw.x), bfhi(bw.x), bflo(bw.y), bfhi(bw.y)}, b1 = {bflo(bw.z), bfhi(bw.z), bflo(bw.w), bfhi(bw.w)};
#pragma unroll
            for (int ai = 0; ai < 2; ++ai)
#pragma unroll
                for (int m = 0; m < 4; ++m) { const int lr = lrow0 + ai * 128 + m * 16; const int slot = u.orow0 + lr;
                    if (lr < u.cnt) { const float gt = gtab[u.idx * 256 + lr] * YSCALE;
                        const f32x4 v0 = (acc[ai][bj][m][0] * WSCALE_INV + b0) * gt, v1 = (acc[ai][bj][m][1] * WSCALE_INV + b1) * gt;
                        *(v2u*)(Y1 + (size_t)slot * 1024 + col0 + bj * 128) = (v2u){pk4_fp8(v0[0], v0[1], v0[2], v0[3]), pk4_fp8(v1[0], v1[1], v1[2], v1[3])}; } }
            asm volatile("" ::: "memory"); }
    }
};
struct MoeOrder {
    const int* tiles; int t_lo, t_hi, NN, G, c; const int* slot_tok; int bstride;
    __device__ __forceinline__ bool next(int i, pg8::Unit& u) const {
        const int nM = t_hi - t_lo, nN = NN, nwg = nM * nN;
        const long L = (long)i * G + c; if (L >= nwg) return false;
        int wgid = (int)L; { const int q = nwg / 8, r = nwg % 8, xcd = wgid % 8, off = wgid / 8; wgid = (xcd < r ? xcd * (q + 1) : r * (q + 1) + (xcd - r) * q) + off; }
        const int nig = 8 * nN, gid = wgid / nig, fm = gid * 8, gsz = (nM - fm) < 8 ? (nM - fm) : 8;
        const int pm = t_lo + fm + ((wgid % nig) % gsz), pn = (wgid % nig) / gsz;
        const int e = __builtin_amdgcn_readfirstlane(tiles[4 * pm]), row0 = __builtin_amdgcn_readfirstlane(tiles[4 * pm + 1]), cnt = __builtin_amdgcn_readfirstlane(tiles[4 * pm + 2]);
        u.e = e; u.arow0 = row0; u.orow0 = row0; u.cnt = cnt; u.rows = slot_tok + row0; u.idx = i; u.brow0 = e * bstride + pn * 256; u.ocol0 = (NN == 8) ? pn * 128 : pn * 256; return true;
    }
    __device__ __forceinline__ void desc(int i, int& e, int& row0, int& cnt, int& ocol0) const {
        const int nM = t_hi - t_lo, nN = NN, nwg = nM * nN; e = 0; row0 = 0; cnt = -1; ocol0 = 0;
        const long L = (long)i * G + c; if (L >= nwg) return;
        int wgid = (int)L; { const int q = nwg / 8, r = nwg % 8, xcd = wgid % 8, off = wgid / 8; wgid = (xcd < r ? xcd * (q + 1) : r * (q + 1) + (xcd - r) * q) + off; }
        const int nig = 8 * nN, gid = wgid / nig, fm = gid * 8, gsz = (nM - fm) < 8 ? (nM - fm) : 8;
        const int pm = t_lo + fm + ((wgid % nig) % gsz), pn = (wgid % nig) / gsz;
        e = tiles[4 * pm]; row0 = tiles[4 * pm + 1]; cnt = tiles[4 * pm + 2]; ocol0 = (NN == 8) ? pn * 128 : pn * 256;
    }
};
template <int NN> struct MoeOrderL {
    const LAS int* ud; const int* slot_tok; int bstride;
    __device__ __forceinline__ bool next(int i, pg8::Unit& u) const {
        const int cnt = __builtin_amdgcn_readfirstlane(ud[i * 4 + 3]); if (cnt < 0) return false;
        const int e = __builtin_amdgcn_readfirstlane(ud[i * 4]), oc = __builtin_amdgcn_readfirstlane(ud[i * 4 + 1]), row0 = __builtin_amdgcn_readfirstlane(ud[i * 4 + 2]);
        u.e = e; u.arow0 = row0; u.orow0 = row0; u.cnt = cnt; u.rows = slot_tok + row0; u.idx = i; u.ocol0 = oc; u.brow0 = e * bstride + ((NN == 8) ? oc * 2 : oc); return true; }
};

__device__ __forceinline__ void p2_qkstats(Frame& F, unsigned* qkn) {
    const bf16* PROJ = (const bf16*)(F.ws + WS_PROJ); float* KM = (float*)(F.ws + WS_TAB + TAB_KMEAN);
    const int gw = F.vcu * NWAVES + F.wave, NGW = F.G * NWAVES;
    for (int u2 = gw; u2 < BATCH * 16 * NH * 2; u2 += NGW) {
        const int which = u2 & 1, u = u2 >> 1, h = u & 7, bb = u >> 3, b = bb >> 4, blk = bb & 15; const int ch = F.lane & 7, ts = F.lane >> 3;
        const bf16* kp = PROJ + ((size_t)b * SEQ + blk * 256 + ts) * INW_PAD + (which ? 0 : ATTN_W) + h * 64 + ch * 8;
        float s[8]; float mx = 0.f;
#pragma unroll
        for (int j = 0; j < 8; ++j) s[j] = 0.f;
#pragma unroll 8
        for (int i = 0; i < 32; ++i) { const v4u w = *(const v4u*)(kp + (size_t)(8 * i) * INW_PAD);
            const float a0 = bflo(w.x), a1 = bfhi(w.x), a2 = bflo(w.y), a3 = bfhi(w.y), a4 = bflo(w.z), a5 = bfhi(w.z), a6 = bflo(w.w), a7 = bfhi(w.w);
            s[0] += a0; s[1] += a1; s[2] += a2; s[3] += a3; s[4] += a4; s[5] += a5; s[6] += a6; s[7] += a7;
            float n2 = (a0 * a0 + a1 * a1) + (a2 * a2 + a3 * a3) + (a4 * a4 + a5 * a5) + (a6 * a6 + a7 * a7);
            n2 += __shfl_xor(n2, 1); n2 += __shfl_xor(n2, 2); n2 += __shfl_xor(n2, 4);
            mx = fmaxf(mx, n2); }
        mx = fmaxf(mx, __shfl_xor(mx, 8)); mx = fmaxf(mx, __shfl_xor(mx, 16)); mx = fmaxf(mx, __shfl_xor(mx, 32));
        if (F.lane == 0) atomicMax(qkn + (b * NH + h) * 2 + (which ? 0 : 1), __float_as_uint(mx));
        if (!which) {
#pragma unroll
            for (int j = 0; j < 8; ++j) { s[j] += __shfl_xor(s[j], 8); s[j] += __shfl_xor(s[j], 16); s[j] += __shfl_xor(s[j], 32); }
            if (ts == 0) { float* o = KM + (((size_t)b * NH + h) * 16 + blk) * 64 + ch * 8;
                *(f32x4*)o = (f32x4){s[0], s[1], s[2], s[3]} * (1.f / 256.f); *(f32x4*)(o + 4) = (f32x4){s[4], s[5], s[6], s[7]} * (1.f / 256.f); } }
    }
}

struct RwkvPrepOut { bf16 *R, *W, *K, *V, *KK, *BV, *G; float* bonus; };
__device__ __forceinline__ void p2_rwkv_prep(Frame& F, const float* mu, const float* w0, const float* w2, const float* a0, const float* a2, const float* g2,
                                             const float* k_k, const float* k_a, const float* r_k, const RwkvPrepOut& O) {
    const bf16* PROJ = (const bf16*)(F.ws + WS_PROJ);
    const int c = F.tid;
    float cw2[32], ca2[32], cg2[96];
#pragma unroll
    for (int j = 0; j < 32; ++j) { cw2[j] = w2[j * 512 + c]; ca2[j] = a2[j * 512 + c]; }
#pragma unroll
    for (int j = 0; j < 96; ++j) cg2[j] = g2[j * 512 + c];
    const float mu_r = mu[c], mu_k = mu[512 + c], mu_v = mu[1024 + c], mu_d = (c < 160) ? mu[1536 + c] : 0.f;
    const float w0c = w0[c], a0c = a0[c], kkc = k_k[c], kac = k_a[c], rkc = r_k[c];
    LAS float* lin = (LAS float*)(F.lds + RING_OFF);
    constexpr int TB = 16;
    const int ntb = T_TOK / TB;
    for (int tb = F.vcu; tb < ntb; tb += F.G) {
        const int t0 = tb * TB;
        __syncthreads();
        if (c < 160) {
#pragma unroll 4
            for (int i = 0; i < TB; ++i) { const int t = t0 + i; const bool first = (t % SEQ) == 0;
                const float xc = bf2f(PROJ[(size_t)t * INW_PAD + XR_OFF + 1536 + c]);
                const float xp = first ? 0.f : bf2f(PROJ[(size_t)(t - 1) * INW_PAD + XR_OFF + 1536 + c]);
                const float xs = xc + (xp - xc) * mu_d;
                float f; if (c < 32) f = tanhf(xs); else if (c < 64) f = xs; else f = sigmoidf_(xs);
                lin[i * 160 + c] = f; }
        }
        __syncthreads();
        for (int i = 0; i < TB; ++i) { const int t = t0 + i; const bool first = (t % SEQ) == 0;
            const bf16* pc = PROJ + (size_t)t * INW_PAD + XR_OFF; const bf16* pp = pc - INW_PAD;
            const float rc_ = bf2f(pc[c]), kc_ = bf2f(pc[512 + c]), vc_ = bf2f(pc[1024 + c]);
            const float rp_ = first ? 0.f : bf2f(pp[c]), kp_ = first ? 0.f : bf2f(pp[512 + c]), vp_ = first ? 0.f : bf2f(pp[1024 + c]);
            const float r = rc_ + (rp_ - rc_) * mu_r, k = kc_ + (kp_ - kc_) * mu_k, v = vc_ + (vp_ - vc_) * mu_v;
            float wp = w0c, ap = a0c, g = 0.f;
            const LAS float* li = lin + i * 160;
#pragma unroll
            for (int j = 0; j < 32; ++j) { wp += li[j] * cw2[j]; ap += li[32 + j] * ca2[j]; }
#pragma unroll
            for (int j = 0; j < 96; ++j) g += li[64 + j] * cg2[j];
            const float w = __expf(-DECAY_SCALE * sigmoidf_(wp)), a = sigmoidf_(ap);
            float kk = k * kkc; const float ss = wave_sum(kk * kk); kk = kk * (1.0f / sqrtf(fmaxf(ss, 1e-24f)));
            const float k2 = k * (1.0f + (a - 1.0f) * kac), bv = kk * a;
            const float bon = wave_sum(r * k2 * rkc);
            const size_t o = (size_t)t * 512 + c;
            O.R[o] = (bf16)f2bf(r); O.W[o] = (bf16)f2bf(w); O.K[o] = (bf16)f2bf(k2); O.V[o] = (bf16)f2bf(v); O.KK[o] = (bf16)f2bf(kk); O.BV[o] = (bf16)f2bf(bv); O.G[o] = (bf16)f2bf(g);
            if (F.lane == 0) O.bonus[(size_t)t * 8 + F.wave] = bon;
        }
    }
}
namespace att {
using bf16x8 = __attribute__((ext_vector_type(8))) short;
using s16x4 = __attribute__((ext_vector_type(4))) short;
using f32x16 = __attribute__((ext_vector_type(16))) float;
using u32x4 = __attribute__((ext_vector_type(4))) unsigned;
constexpr int D = 64, DM = INW_PAD, OP = INW_PAD;
constexpr int NW = 8, QBLK = 32, QB = QBLK * NW, KVBLK = 64, NQB = SEQ / QB;
constexpr float C2 = 0.125f * 1.4426950408889634f;
constexpr float THR = 8.0f;
constexpr int SLOTB = 8192, LDS_K = 0, LDS_V = 3 * SLOTB, LDS_WS = 6 * SLOTB, LDS_OST = LDS_WS + NW * 256, LDS_BYTES = LDS_OST + NW * 8192;
#define SBAR() __builtin_amdgcn_sched_barrier(0)
#define PIN(x) asm volatile("" : "+v"(x))
#define MFMA(a, b, c) __builtin_amdgcn_mfma_f32_32x32x16_bf16(a, b, c, 0, 0, 0)
#define WAIT_BAR(N) asm volatile("s_waitcnt vmcnt(" #N ") lgkmcnt(0)\n\ts_barrier" ::: "memory")
__device__ __forceinline__ int crow(int r, int hi) { return (r & 3) + 8 * (r >> 2) + 4 * hi; }
__device__ __forceinline__ unsigned cvtpk(float lo, float hi) { unsigned r; asm("v_cvt_pk_bf16_f32 %0, %1, %2" : "=v"(r) : "v"(lo), "v"(hi)); return r; }
__device__ __forceinline__ void glds16_nt(const void* g, unsigned lds_base) {
    unsigned sv; asm volatile("s_mov_b32 %0, m0\n\ts_mov_b32 m0, %2\n\ts_nop 0\n\tglobal_load_lds_dwordx4 %1, off nt\n\ts_mov_b32 m0, %0" : "=&s"(sv) : "v"(g), "s"(lds_base) : "memory"); }
__device__ __forceinline__ void glds16(const void* g, unsigned lds_base) {
    unsigned sv; asm volatile("s_mov_b32 %0, m0\n\ts_mov_b32 m0, %2\n\ts_nop 0\n\tglobal_load_lds_dwordx4 %1, off\n\ts_mov_b32 m0, %0" : "=&s"(sv) : "v"(g), "s"(lds_base) : "memory"); }
typedef __attribute__((address_space(3))) const char* lds_cptr;
typedef short v4i16_t __attribute__((ext_vector_type(4)));
__device__ __forceinline__ void kload2(bf16x8* kf, lds_cptr kp, int d0) { kf[2 * d0] = *(const __attribute__((address_space(3))) bf16x8*)(kp + d0 * 2048); kf[2 * d0 + 1] = *(const __attribute__((address_space(3))) bf16x8*)(kp + d0 * 2048 + 512); }
__device__ __forceinline__ s16x4 vtr(lds_cptr p) { return __builtin_bit_cast(s16x4, __builtin_amdgcn_ds_read_tr16_b64_v4i16((__attribute__((address_space(3))) v4i16_t*)p)); }
#define MX3(a, b, c) __builtin_fmaxf(__builtin_fmaxf((a), (b)), (c))
__device__ __forceinline__ float max16(const f32x16& p) {
    float a = MX3(p[0], p[1], p[2]), b = MX3(p[3], p[4], p[5]); a = MX3(a, p[6], p[7]); b = MX3(b, p[8], p[9]); a = MX3(a, p[10], p[11]); b = MX3(b, p[12], p[13]); a = MX3(a, p[14], p[15]);
    return __builtin_fmaxf(a, b); }
__device__ __forceinline__ float rowmax(const f32x16& p0, const f32x16& p1, float b32) {
    const float m = __builtin_fmaxf(max16(p0), max16(p1) + b32); auto rr = __builtin_amdgcn_permlane32_swap(__float_as_uint(m), __float_as_uint(m), false, false);
    return __builtin_fmaxf(__uint_as_float(rr[0]), __uint_as_float(rr[1])); }
__device__ __forceinline__ void cmask(f32x16& p0, f32x16& p1, int jb, int qrel, int hi) {
    const int kb = 64 * jb + 4 * hi;
#pragma unroll
    for (int r = 0; r < 16; ++r) { const int kv = kb + (r & 3) + 8 * (r >> 2); if (kv > qrel) p0[r] = -INFINITY; if (kv + 32 > qrel) p1[r] = -INFINITY; } }

__device__ __forceinline__ void attn_unit(int b, int h, int qb, const bf16* P, const float* KM, const unsigned* qkn, const float* gnorm, bf16* O, char* lds) {
    asm volatile("" : "+s"(b), "+s"(h), "+s"(qb));
    int tid = threadIdx.x; asm volatile("" : "+v"(tid));
    const int lane = tid & 63, r32 = lane & 31, hi = lane >> 5; const int wid = __builtin_amdgcn_readfirstlane(tid >> 6);
    const long rowbase = (long)b * SEQ; const int q0 = qb * QB;
    int t_start;
    { const float beta_ = __builtin_amdgcn_exp2f(-(float)(h + 1)) * 1.4426950408889634f;
      const float qm = sqrtf(__uint_as_float(__builtin_amdgcn_readfirstlane(qkn[(b * NH + h) * 2]))), km = sqrtf(__uint_as_float(__builtin_amdgcn_readfirstlane(qkn[(b * NH + h) * 2 + 1])));
      const float dk = (40.0f + 2.0f * C2 * qm * km) / beta_;
      const float ts = floorf(((float)(q0 + 1) - dk) * (1.0f / 64.0f));
      t_start = (ts > 0.f) ? ((int)ts & ~1) : 0; t_start = __builtin_amdgcn_readfirstlane(t_start); }
    const int NT = (q0 + QB) / KVBLK - t_start;
    const bf16* Qw = P + (rowbase + q0 + wid * QBLK) * DM + h * D;
    const bf16* K = P + ATTN_W; const bf16* V = P + 2 * ATTN_W;
    const unsigned lds0 = (unsigned)(uintptr_t)lds; float* wsf = (float*)(lds + LDS_WS) + wid * 64;
    const bf16* ksrc = K + (rowbase + (long)t_start * KVBLK) * DM + h * D + (long)lane * DM + wid * 8;
    const bf16* vsrc = V + (rowbase + (long)t_start * KVBLK) * DM + h * D + (long)(16 * (wid & 3) + (lane >> 2)) * DM + (wid >> 2) * 32 + (lane & 3) * 8;
    const unsigned kdst = lds0 + LDS_K + wid * 1024, vdst = lds0 + LDS_V + wid * 1024;
#define DMA_K(t, slot) glds16(ksrc + (long)(t) * KVBLK * DM, (unsigned)__builtin_amdgcn_readfirstlane(kdst + (slot)))
#define DMA_V(t, slot) glds16(vsrc + (long)(t) * KVBLK * DM, (unsigned)__builtin_amdgcn_readfirstlane(vdst + (slot)))
    const lds_cptr vp0 = (lds_cptr)lds + LDS_V + ((lane >> 4) & 1) * 32 + (lane & 3) * 8 + (4 * hi + ((lane & 15) >> 2)) * 64;
    const lds_cptr kp0 = (lds_cptr)lds + LDS_K + hi * 1024 + r32 * 16;
    DMA_K(0, 0); DMA_V(0, 0); DMA_K(1, SLOTB);
    bf16x8 qr[4];
#pragma unroll
    for (int d0 = 0; d0 < 4; ++d0) qr[d0] = *reinterpret_cast<const bf16x8*>(&Qw[(long)r32 * DM + d0 * 16 + hi * 8]);
    unsigned selmask = 0u;
    {
        f32x16 ga = f32x16{};
        int tg = threadIdx.x; asm volatile("" : "+v"(tg)); const int r32g = tg & 31, hig = (tg >> 5) & 1;
        const float* kmp = KM + (((size_t)b * NH + h) * 16 + (r32g & 15)) * 64 + hig * 8;
#pragma unroll
        for (int d0 = 0; d0 < 4; ++d0) {
            const f32x4 x0 = *(const f32x4*)(kmp + d0 * 16), x1 = *(const f32x4*)(kmp + d0 * 16 + 4);
            float xv[8] = {x0[0], x0[1], x0[2], x0[3], x1[0], x1[1], x1[2], x1[3]}; unsigned wh[4], wl[4];
#pragma unroll
            for (int j = 0; j < 4; ++j) { const float a0 = (r32g < 16) ? xv[2 * j] : 0.f, a1 = (r32g < 16) ? xv[2 * j + 1] : 0.f; wh[j] = cvtpk(a0, a1);
                const float l0 = a0 - bflo(wh[j]), l1 = a1 - bfhi(wh[j]); wl[j] = cvtpk(l0, l1); }
            const bf16x8 fh = __builtin_bit_cast(bf16x8, (u32x4){wh[0], wh[1], wh[2], wh[3]}), fl = __builtin_bit_cast(bf16x8, (u32x4){wl[0], wl[1], wl[2], wl[3]});
            ga = MFMA(fh, qr[d0], ga); ga = MFMA(fl, qr[d0], ga);
        }
        float g[16];
#pragma unroll
        for (int r = 0; r < 8; ++r) { auto rr = __builtin_amdgcn_permlane32_swap(__float_as_uint(ga[r]), __float_as_uint(ga[r]), false, false);
            const int blk = (r & 3) + 8 * (r >> 2); g[blk] = __uint_as_float(rr[0]); g[blk + 4] = __uint_as_float(rr[1]); }
#pragma unroll
        for (int rnd = 0; rnd < 3; ++rnd) { float best = -3e38f; int bi = -1;
#pragma unroll
            for (int j = 0; j < 16; ++j) { const bool ok = (j < qb) && !((selmask >> j) & 1u) && (g[j] > best); best = ok ? g[j] : best; bi = ok ? j : bi; }
            selmask |= (bi >= 0) ? (1u << bi) : 0u; }
    }
    const float slope = __builtin_amdgcn_exp2f(-(float)(h + 1)), beta = slope * 1.4426950408889634f, b32 = 32.0f * beta / C2, beta32 = 32.0f * beta;
    f32x16 bias16;
#pragma unroll
    for (int r = 0; r < 16; ++r) bias16[r] = (beta / C2) * (float)crow(r, hi);
    PIN(bias16);
    float mhat = -1e30f, l_reg = 0.f; f32x16 o[2]; o[0] = f32x16{}; o[1] = f32x16{};
    const int qrel = wid * QBLK + r32; bool resc = false;
    f32x16 pA0, pA1, pB0, pB1; bf16x8 kf[8]; s16x4 vlo[8], vhi[8]; u32x4 pw0, pw1, pw2, pw3;
    int sl_prev = 0, sl_cur = 0, sl_next = SLOTB;
#define ROT() do { sl_prev = sl_cur; sl_cur = sl_next; sl_next = (sl_next == 2 * SLOTB) ? 0 : sl_next + SLOTB; } while (0)
#define EX0(v) __builtin_amdgcn_exp2f(__builtin_fmaf((v), C2, nmh0))
#define EX1(v) __builtin_amdgcn_exp2f(__builtin_fmaf((v), C2, nmh1))
#define RESC() do { if (resc) { _Pragma("unroll") for (int d_ = 0; d_ < 2; ++d_) _Pragma("unroll") for (int r = 0; r < 16; ++r) o[d_][r] *= wsf[crow(r, hi)]; } } while (0)
#define DECIDE(C0, C1, tt) \
      const bool lsel_ = ((tt) >= NT - 4) || (((selmask >> (((tt) + t_start) >> 2)) & 1u) != 0u); \
      const float bs0_ = beta * (float)(((tt) + t_start) * KVBLK); \
      float rmabs_ = __builtin_fmaf(rowmax(C0, C1, b32), C2, bs0_); rmabs_ = lsel_ ? rmabs_ : -1e30f; resc = false; \
      if (__any((rmabs_ - mhat) > THR)) { const float mnew_ = __builtin_fmaxf(mhat, rmabs_); const float f_ = __builtin_amdgcn_exp2f(mhat - mnew_); mhat = mnew_; l_reg *= f_; if (hi == 0) wsf[r32] = f_; resc = true; } \
      const float nmh0 = lsel_ ? (bs0_ - mhat) : -INFINITY; const float nmh1 = nmh0 + beta32;
    DMA_K(2, 2 * SLOTB);
    WAIT_BAR(3);
    _Pragma("unroll") for (int d0 = 0; d0 < 4; ++d0) kload2(kf, kp0, d0);
    pA0 = MFMA(kf[0], qr[0], bias16); pA1 = MFMA(kf[1], qr[0], bias16); pA0 = MFMA(kf[2], qr[1], pA0); pA1 = MFMA(kf[3], qr[1], pA1);
    pA0 = MFMA(kf[4], qr[2], pA0); pA1 = MFMA(kf[5], qr[2], pA1); pA0 = MFMA(kf[6], qr[3], pA0); pA1 = MFMA(kf[7], qr[3], pA1);
    if (NT == 4) cmask(pA0, pA1, 0, qrel, hi);
    { DECIDE(pA0, pA1, 0)
#pragma unroll
      for (int r = 0; r < 16; ++r) { pA0[r] = EX0(pA0[r]); pA1[r] = EX1(pA1[r]); } }
    WAIT_BAR(0);
    RESC();
    DMA_K(3, 0); DMA_V(1, SLOTB); ROT();
    _Pragma("unroll") for (int d0 = 0; d0 < 4; ++d0) kload2(kf, kp0 + sl_cur, d0);
    WAIT_BAR(2);
#define PKW(P_, i) cvtpk(P_[i], P_[i + 1])
#define PAF(k) __builtin_bit_cast(bf16x8, pw##k)
#define VFR(i) (bf16x8){vlo[i][0], vlo[i][1], vlo[i][2], vlo[i][3], vhi[i][0], vhi[i][1], vhi[i][2], vhi[i][3]}
#define VRD(i) do { vlo[i] = vtr(vp_ + (((i) >> 2) * 4096 + ((i) & 3) * 1024)); vhi[i] = vtr(vp_ + (((i) >> 2) * 4096 + ((i) & 3) * 1024 + 512)); } while (0)
#define KRD(G, d0) do { if (G) { kload2(kf, kp0 + sl_next, d0); SBAR(); } } while (0)
#define GAPA(MF, a0, a1, a2, a3, W0, W1, PW) do { MF; sacc += a0; sacc += a1; sacc += a2; sacc += a3; W0; W1; PIN(PW); PIN(sacc); SBAR(); } while (0)
#define GAPB0(MF, X, i) do { MF; X[i] = EX0(X[i]); X[i + 1] = EX0(X[i + 1]); X[i + 2] = EX0(X[i + 2]); X[i + 3] = EX0(X[i + 3]); PIN(X); SBAR(); } while (0)
#define GAPB1(MF, X, i) do { MF; X[i] = EX1(X[i]); X[i + 1] = EX1(X[i + 1]); X[i + 2] = EX1(X[i + 2]); X[i + 3] = EX1(X[i + 3]); PIN(X); SBAR(); } while (0)
#define STEP(C0, C1, P0, P1, t, MASK, GK, GV, GL) do { SBAR(); \
    const lds_cptr vp_ = vp0 + sl_prev; \
    VRD(0); SBAR(); float sacc = P0[0] + P0[1]; \
                    GAPA(C0 = MFMA(kf[0], qr[0], bias16), P0[2], P0[3], P0[4], P0[5],     pw0[0] = PKW(P0, 0),  pw0[1] = PKW(P0, 2),  pw0); \
    VRD(4); SBAR(); GAPA(C1 = MFMA(kf[1], qr[0], bias16), P0[6], P0[7], P0[8], P0[9],     pw0[2] = PKW(P0, 4),  pw0[3] = PKW(P0, 6),  pw0); \
    VRD(1); SBAR(); GAPA(C0 = MFMA(kf[2], qr[1], C0),    P0[10], P0[11], P0[12], P0[13], pw1[0] = PKW(P0, 8),  pw1[1] = PKW(P0, 10), pw1); \
    VRD(5); SBAR(); GAPA(C1 = MFMA(kf[3], qr[1], C1),    P0[14], P0[15], P1[0], P1[1],   pw1[2] = PKW(P0, 12), pw1[3] = PKW(P0, 14), pw1); \
    VRD(2); SBAR(); GAPA(C0 = MFMA(kf[4], qr[2], C0),    P1[2], P1[3], P1[4], P1[5],     pw2[0] = PKW(P1, 0),  pw2[1] = PKW(P1, 2),  pw2); \
    VRD(6); SBAR(); GAPA(C1 = MFMA(kf[5], qr[2], C1),    P1[6], P1[7], P1[8], P1[9],     pw2[2] = PKW(P1, 4),  pw2[3] = PKW(P1, 6),  pw2); \
    VRD(3); SBAR(); GAPA(C0 = MFMA(kf[6], qr[3], C0),    P1[10], P1[11], P1[12], P1[13], pw3[0] = PKW(P1, 8),  pw3[1] = PKW(P1, 10), pw3); \
    VRD(7); SBAR(); GAPA(C1 = MFMA(kf[7], qr[3], C1),    P1[14], P1[15], 0.f, 0.f,       pw3[2] = PKW(P1, 12), pw3[3] = PKW(P1, 14), pw3); \
    l_reg += sacc; \
    if (GK) DMA_K((t) + 3, sl_cur); if (GV) DMA_V((t) + 1, sl_next); \
    if (MASK) cmask(C0, C1, (t) - (NT - 4), qrel, hi); \
    DECIDE(C0, C1, t) \
    SBAR(); \
    GAPB0(o[0] = MFMA(PAF(0), VFR(0), o[0]), C0, 0);              GAPB0(o[1] = MFMA(PAF(0), VFR(4), o[1]), C0, 4); \
    KRD(GL, 0); GAPB0(o[0] = MFMA(PAF(1), VFR(1), o[0]), C0, 8);  KRD(GL, 1); GAPB0(o[1] = MFMA(PAF(1), VFR(5), o[1]), C0, 12); \
    KRD(GL, 2); GAPB1(o[0] = MFMA(PAF(2), VFR(2), o[0]), C1, 0);  KRD(GL, 3); GAPB1(o[1] = MFMA(PAF(2), VFR(6), o[1]), C1, 4); \
    GAPB1(o[0] = MFMA(PAF(3), VFR(3), o[0]), C1, 8);              GAPB1(o[1] = MFMA(PAF(3), VFR(7), o[1]), C1, 12); \
    } while (0)
    int t = 1;
    for (; t + 5 < NT; t += 2) {
        STEP(pB0, pB1, pA0, pA1, t, false, true, true, true);     WAIT_BAR(2); RESC(); ROT();
        STEP(pA0, pA1, pB0, pB1, t + 1, false, true, true, true); WAIT_BAR(2); RESC(); ROT();
    }
#define ENDW(tt) do { if ((tt) + 3 < NT) { WAIT_BAR(2); } else if ((tt) + 2 < NT) { WAIT_BAR(1); } else { WAIT_BAR(0); } } while (0)
    for (; t + 1 < NT; t += 2) {
        STEP(pB0, pB1, pA0, pA1, t, true, (t + 3 < NT), (t + 1 < NT), (t + 1 < NT));         ENDW(t);     RESC(); ROT();
        STEP(pA0, pA1, pB0, pB1, t + 1, true, (t + 4 < NT), (t + 2 < NT), (t + 2 < NT));     ENDW(t + 1); RESC(); ROT();
    }
    STEP(pB0, pB1, pA0, pA1, NT - 1, true, false, false, false); asm volatile("s_waitcnt lgkmcnt(0)" ::: "memory"); RESC();
    { float sacc = pB0[0] + pB0[1];
#pragma unroll
      for (int r = 2; r < 16; ++r) sacc += pB0[r];
#pragma unroll
      for (int r = 0; r < 16; ++r) sacc += pB1[r];
      l_reg += sacc;
      pw0 = (u32x4){PKW(pB0, 0), PKW(pB0, 2), PKW(pB0, 4), PKW(pB0, 6)}; pw1 = (u32x4){PKW(pB0, 8), PKW(pB0, 10), PKW(pB0, 12), PKW(pB0, 14)};
      pw2 = (u32x4){PKW(pB1, 0), PKW(pB1, 2), PKW(pB1, 4), PKW(pB1, 6)}; pw3 = (u32x4){PKW(pB1, 8), PKW(pB1, 10), PKW(pB1, 12), PKW(pB1, 14)};
      const lds_cptr vp_ = vp0 + sl_cur; _Pragma("unroll") for (int i = 0; i < 8; ++i) VRD(i);
      o[0] = MFMA(PAF(0), VFR(0), o[0]); o[1] = MFMA(PAF(0), VFR(4), o[1]); o[0] = MFMA(PAF(1), VFR(1), o[0]); o[1] = MFMA(PAF(1), VFR(5), o[1]);
      o[0] = MFMA(PAF(2), VFR(2), o[0]); o[1] = MFMA(PAF(2), VFR(6), o[1]); o[0] = MFMA(PAF(3), VFR(3), o[0]); o[1] = MFMA(PAF(3), VFR(7), o[1]); }
    { auto rr = __builtin_amdgcn_permlane32_swap(__float_as_uint(l_reg), __float_as_uint(l_reg), false, false); l_reg = __uint_as_float(rr[0]) + __uint_as_float(rr[1]); }
    int te = threadIdx.x; asm volatile("" : "+v"(te));
    const int lane_e = te & 63, r32e = lane_e & 31, hie = lane_e >> 5; const int wide = __builtin_amdgcn_readfirstlane(te >> 6);
    float* wsfe = (float*)(lds + LDS_WS) + wide * 64;
    if (hie == 0) wsfe[32 + r32e] = l_reg; asm volatile("s_waitcnt lgkmcnt(0)" ::: "memory");
    bf16* Ow = O + (rowbase + q0 + wide * QBLK) * OP + h * D; float* stg = (float*)(lds + LDS_OST) + wide * 2048;
#pragma unroll
    for (int r = 0; r < 16; ++r) { const int orow = crow(r, hie); const float rl = __builtin_amdgcn_rcpf(wsfe[32 + orow]);
#pragma unroll
        for (int d0 = 0; d0 < 2; ++d0) stg[orow * 64 + d0 * 32 + r32e] = o[d0][r] * rl; }
    asm volatile("s_waitcnt lgkmcnt(0)" ::: "memory");
#pragma unroll
    for (int i = 0; i < 4; ++i) { const int row = i * 8 + (lane_e >> 3), ch = lane_e & 7;
        const f32x4 a = *(const f32x4*)(stg + row * 64 + ch * 8), c = *(const f32x4*)(stg + row * 64 + ch * 8 + 4);
        float ss = (a[0] * a[0] + a[1] * a[1]) + (a[2] * a[2] + a[3] * a[3]) + (c[0] * c[0] + c[1] * c[1]) + (c[2] * c[2] + c[3] * c[3]);
        ss += __shfl_xor(ss, 1); ss += __shfl_xor(ss, 2); ss += __shfl_xor(ss, 4);
        const float rn = 1.0f / sqrtf(ss * (1.f / 64.f) + NORM_EPS);
        const f32x4 g0 = *(const f32x4*)(gnorm + h * 64 + ch * 8), g1 = *(const f32x4*)(gnorm + h * 64 + ch * 8 + 4);
        u32x4 w; w.x = cvtpk(a[0] * rn * g0[0], a[1] * rn * g0[1]); w.y = cvtpk(a[2] * rn * g0[2], a[3] * rn * g0[3]); w.z = cvtpk(c[0] * rn * g1[0], c[1] * rn * g1[1]); w.w = cvtpk(c[2] * rn * g1[2], c[3] * rn * g1[3]);
        *(u32x4*)(Ow + (long)row * OP + ch * 8) = w; asm volatile("" ::: "memory"); }
    asm volatile("s_waitcnt lgkmcnt(0)\n\ts_barrier" ::: "memory");
#undef DMA_K
#undef DMA_V
#undef ROT
#undef EX0
#undef EX1
#undef RESC
#undef DECIDE
#undef PKW
#undef PAF
#undef VFR
#undef VRD
#undef KRD
#undef ENDW
#undef GAPA
#undef GAPB0
#undef GAPB1
#undef STEP
}
#undef SBAR
#undef PIN
#undef MFMA
#undef WAIT_BAR
#undef MX3
__device__ __forceinline__ void attn_phase(unsigned* qh, volatile __attribute__((address_space(3))) unsigned* bc, const bf16* P, const float* KM, const unsigned* qkn, const float* gnorm, bf16* O, char* lds) {
    const int grp = blockIdx.x & 7; int k = 0;
    for (;;) {
        if (threadIdx.x == 0) { int unit = -1;
            while (k < 8) { const int q = (grp + k) & 7; const unsigned p = __hip_atomic_fetch_add(qh + 64 * q, 1u, __ATOMIC_RELAXED, __HIP_MEMORY_SCOPE_AGENT); if (p < 64u) { unit = q * 64 + (int)p; break; } ++k; }
            bc[0] = (unsigned)unit; }
        __syncthreads();
        const int p = (int)bc[0];
        __syncthreads();
        if (p < 0) break;
        const int bb = p >> 6, hh = 7 - ((p >> 3) & 7), j = p & 7;
        attn_unit(bb, hh, j, P, KM, qkn, gnorm, O, lds);
        attn_unit(bb, hh, 15 - j, P, KM, qkn, gnorm, O, lds);
    }
}
}
namespace rw {
using bf16x8 = __attribute__((ext_vector_type(8))) short;
using s16x4 = __attribute__((ext_vector_type(4))) short;
using f32x16 = __attribute__((ext_vector_type(16))) float;
using u32x4 = __attribute__((ext_vector_type(4))) unsigned;
using u32x2 = __attribute__((ext_vector_type(2))) unsigned;
#define RMFMA(a, b, c) __builtin_amdgcn_mfma_f32_32x32x16_bf16(a, b, c, 0, 0, 0)
typedef __attribute__((address_space(3))) const char* lds_cptr;
typedef __attribute__((address_space(3))) char* lds_ptr;
typedef short v4i16_t __attribute__((ext_vector_type(4)));
typedef float f32x2_t __attribute__((ext_vector_type(2))); typedef __bf16 bf16x2_t __attribute__((ext_vector_type(2)));
__device__ __forceinline__ unsigned cvtpk(float lo, float hi) { f32x2_t v = {lo, hi}; bf16x2_t b = __builtin_convertvector(v, bf16x2_t); return __builtin_bit_cast(unsigned, b); }
__device__ __forceinline__ int crow(int r, int hi) { return (r & 3) + 8 * (r >> 2) + 4 * hi; }
__device__ __forceinline__ s16x4 vtr(lds_cptr p) { return __builtin_bit_cast(s16x4, __builtin_amdgcn_ds_read_tr16_b64_v4i16((__attribute__((address_space(3))) v4i16_t*)p)); }
__device__ __forceinline__ bf16x8 pack8(const f32x16& x, int s) {
    return __builtin_bit_cast(bf16x8, (u32x4){cvtpk(x[8 * s], x[8 * s + 1]), cvtpk(x[8 * s + 2], x[8 * s + 3]), cvtpk(x[8 * s + 4], x[8 * s + 5]), cvtpk(x[8 * s + 6], x[8 * s + 7])}); }
__device__ __forceinline__ void fill_img(lds_ptr img, const bf16* g, int lane) {
    unsigned go = (unsigned)((lane >> 3) * 1024 + (lane & 7) * 16); const int ch = lane & 7; const lds_ptr ip = img + (ch >> 2) * 4096 + (lane >> 3) * 64 + (ch & 3) * 16;
#pragma unroll
    for (int it = 0; it < 8; ++it) { const u32x4 w = *(const u32x4*)((const char*)g + go); go += 8192u; asm volatile("" : "+v"(go));
        *(__attribute__((address_space(3))) u32x4*)(ip + it * 512) = w; }
}
__device__ __forceinline__ bf16x8 tr_frag(lds_cptr base  , int ct, int s) {
    const s16x4 lo = vtr(base + ct * 4096 + s * 1024), hi = vtr(base + ct * 4096 + s * 1024 + 512);
    return (bf16x8){lo[0], lo[1], lo[2], lo[3], hi[0], hi[1], hi[2], hi[3]}; }
__device__ __forceinline__ int tr_lane_off(int lane) { const int hi = lane >> 5; return ((lane >> 4) & 1) * 32 + (lane & 3) * 8 + (4 * hi + ((lane & 15) >> 2)) * 64; }
__device__ __forceinline__ bf16x8 row_frag(const bf16* g, int rt, int s, int lane) { const unsigned off = (unsigned)((32 * rt + (lane & 31)) * 1024 + 32 * s + 16 * (lane >> 5)); return *(const bf16x8*)((const char*)g + off); }

struct Bufs { bf16 *KK, *BT, *KT, *RT, *V, *G; float* gamC; float* bonus; bf16* McT; float* GcT; unsigned* U0d; bf16* S0; };
}

__device__ __forceinline__ float row16_sum(float v) {
    v += __builtin_bit_cast(float, __builtin_amdgcn_update_dpp(0, __builtin_bit_cast(int, v), 0xB1, 0xf, 0xf, false));
    v += __builtin_bit_cast(float, __builtin_amdgcn_update_dpp(0, __builtin_bit_cast(int, v), 0x4E, 0xf, 0xf, false));
    v += __builtin_bit_cast(float, __builtin_amdgcn_update_dpp(0, __builtin_bit_cast(int, v), 0x141, 0xf, 0xf, false));
    v += __builtin_bit_cast(float, __builtin_amdgcn_update_dpp(0, __builtin_bit_cast(int, v), 0x140, 0xf, 0xf, false));
    return v;
}
__device__ __forceinline__ void p2_rwkv_prep2(Frame& F, const float* mu, const float* w0, const float* w2, const float* a0, const float* a2, const float* g2,
                                              const float* k_k, const float* k_a, const float* r_k, const rw::Bufs& O, int nrep) {
    typedef float f32x4_t __attribute__((ext_vector_type(4)));
    using rw::bf16x8; using rw::u32x4; using rw::u32x2;
    const bf16* PROJ = (const bf16*)(F.ws + WS_PROJ);
    const int c = F.tid, cl = F.lane & 15, q = F.lane >> 4, ch0 = 64 * F.wave + 4 * cl;
    bf16x8 bw[4], ba[4], bg[3][4];
#pragma unroll
    for (int nt = 0; nt < 4; ++nt) { const int ch = ch0 + nt; unsigned u[4];
#pragma unroll
        for (int e = 0; e < 4; ++e) u[e] = rw::cvtpk(w2[(8 * q + 2 * e) * 512 + ch], w2[(8 * q + 2 * e + 1) * 512 + ch]);
        bw[nt] = __builtin_bit_cast(bf16x8, (u32x4){u[0], u[1], u[2], u[3]});
#pragma unroll
        for (int e = 0; e < 4; ++e) u[e] = rw::cvtpk(a2[(8 * q + 2 * e) * 512 + ch], a2[(8 * q + 2 * e + 1) * 512 + ch]);
        ba[nt] = __builtin_bit_cast(bf16x8, (u32x4){u[0], u[1], u[2], u[3]});
#pragma unroll
        for (int s = 0; s < 3; ++s) {
#pragma unroll
            for (int e = 0; e < 4; ++e) u[e] = rw::cvtpk(g2[(32 * s + 8 * q + 2 * e) * 512 + ch], g2[(32 * s + 8 * q + 2 * e + 1) * 512 + ch]);
            bg[s][nt] = __builtin_bit_cast(bf16x8, (u32x4){u[0], u[1], u[2], u[3]}); } }
    constexpr int TB = 16, ROWB = XR_W * 2, BUFB = 17 * ROWB;
    LAS unsigned char* xbuf = F.lds + RING_OFF;
    LAS unsigned* lin = (LAS unsigned*)(F.lds + RING_OFF + 2 * BUFB);
    const unsigned lds0 = (unsigned)(uintptr_t)(F.lds + RING_OFF);
    auto issue = [&](int tb, int buf) {
        const int t0 = F.vcu * 128 + tb * TB;
        for (int r = F.wave; r < 17; r += NWAVES) { const int t = t0 - 1 + r; if (r == 0 && (t0 % SEQ) == 0) continue;
            const unsigned char* src = (const unsigned char*)(PROJ + (size_t)t * INW_PAD + XR_OFF) + F.lane * 16;
#pragma unroll
            for (int k = 0; k < 4; ++k) if (k * 1024 + F.lane * 16 < ROWB) att::glds16_nt(src + k * 1024, (unsigned)__builtin_amdgcn_readfirstlane(lds0 + buf * BUFB + r * ROWB + k * 1024)); } };
    LAS float* cA = (LAS float*)(F.lds + RING_OFF + 2 * BUFB + 5120); LAS float* cB = (LAS float*)(F.lds + LDSCTL_OFF + 1024);
    { cA[c] = mu[c]; cA[512 + c] = mu[512 + c]; cA[1024 + c] = mu[1024 + c]; cA[1536 + c] = w0[c]; cA[2048 + c] = a0[c];
      cB[c] = k_k[c]; cB[512 + c] = k_a[c]; cB[1024 + c] = r_k[c]; if (c < 160) cB[1536 + c] = mu[1536 + c]; }
    f32x4_t cumc = {0.f, 0.f, 0.f, 0.f};
    issue(0, 0);
    for (int rep = 0; rep < nrep; ++rep)
    for (int tb = 0; tb < 128 / TB; ++tb) {
        const int t0 = F.vcu * 128 + tb * TB; const int buf = tb & 1;
        if (rep == 0 && tb == 0) asm volatile("s_waitcnt vmcnt(0)" ::: "memory");
        else asm volatile("s_waitcnt vmcnt(28)" ::: "memory");
        __syncthreads();
        if (tb + 1 < 128 / TB) issue(tb + 1, buf ^ 1); else if (rep + 1 < nrep) issue(0, buf ^ 1);
        const LAS unsigned short* xb = (const LAS unsigned short*)(xbuf + buf * BUFB);
        for (int pq = c; pq < TB * 80; pq += NTHREADS) {
            const int i = pq / 80, j = pq - i * 80; const int t = t0 + i; const bool first = (t % SEQ) == 0;
            const unsigned wc = *(const LAS unsigned*)(xb + (i + 1) * (ROWB / 2) + 1536 + 2 * j), wp_ = *(const LAS unsigned*)(xb + i * (ROWB / 2) + 1536 + 2 * j);
            const float m0 = cB[1536 + 2 * j], m1 = cB[1536 + 2 * j + 1];
            const float c0 = bflo(wc), c1 = bfhi(wc), p0 = first ? 0.f : bflo(wp_), p1 = first ? 0.f : bfhi(wp_);
            const float x0 = c0 + (p0 - c0) * m0, x1 = c1 + (p1 - c1) * m1;
            float f0, f1; if (j < 16) { f0 = 1.0f - 2.0f * __builtin_amdgcn_rcpf(1.0f + __builtin_amdgcn_exp2f(2.885390081777927f * x0)); f1 = 1.0f - 2.0f * __builtin_amdgcn_rcpf(1.0f + __builtin_amdgcn_exp2f(2.885390081777927f * x1)); }     else if (j < 32) { f0 = x0; f1 = x1; } else { f0 = __builtin_amdgcn_rcpf(1.0f + __expf(-x0)); f1 = __builtin_amdgcn_rcpf(1.0f + __expf(-x1)); }
            lin[i * 80 + j] = rw::cvtpk(f0, f1); }
        __syncthreads();
        if ((t0 & 63) == 0) cumc = (f32x4_t){0.f, 0.f, 0.f, 0.f};
        f32x4_t aW[4], aA[4];
        const unsigned ob = (unsigned)(t0 + 4 * q) * 1024u + (unsigned)ch0 * 2u;
        {
            f32x4_t aG[4];
            const f32x4_t w0c = *(const LAS f32x4_t*)(cA + 1536 + ch0), a0c = *(const LAS f32x4_t*)(cA + 2048 + ch0);
            const LAS unsigned char* lp = (const LAS unsigned char*)lin + cl * 320 + q * 16;
            const bf16x8 fw = *(const LAS bf16x8*)(lp), fa = *(const LAS bf16x8*)(lp + 64), fg0 = *(const LAS bf16x8*)(lp + 128), fg1 = *(const LAS bf16x8*)(lp + 192), fg2 = *(const LAS bf16x8*)(lp + 256);
#pragma unroll
            for (int nt = 0; nt < 4; ++nt) {
                aW[nt] = __builtin_amdgcn_mfma_f32_16x16x32_bf16(fw, bw[nt], (f32x4_t){w0c[nt], w0c[nt], w0c[nt], w0c[nt]}, 0, 0, 0);
                aA[nt] = __builtin_amdgcn_mfma_f32_16x16x32_bf16(fa, ba[nt], (f32x4_t){a0c[nt], a0c[nt], a0c[nt], a0c[nt]}, 0, 0, 0);
                f32x4_t g_ = __builtin_amdgcn_mfma_f32_16x16x32_bf16(fg0, bg[0][nt], (f32x4_t){0.f, 0.f, 0.f, 0.f}, 0, 0, 0);
                g_ = __builtin_amdgcn_mfma_f32_16x16x32_bf16(fg1, bg[1][nt], g_, 0, 0, 0);
                aG[nt] = __builtin_amdgcn_mfma_f32_16x16x32_bf16(fg2, bg[2][nt], g_, 0, 0, 0); }
#pragma unroll
            for (int j = 0; j < 4; ++j) __builtin_nontemporal_store((u32x2){rw::cvtpk(aG[0][j], aG[1][j]), rw::cvtpk(aG[2][j], aG[3][j])}, (u32x2*)((char*)O.G + ob + j * 1024));
        }
        f32x4_t cum[4]; float lw0[4];
#pragma unroll
        for (int nt = 0; nt < 4; ++nt) {
            f32x4_t lw;
#pragma unroll
            for (int j = 0; j < 4; ++j) { lw[j] = -DECAY_SCALE * __builtin_amdgcn_rcpf(1.0f + __expf(-aW[nt][j])); aA[nt][j] = __builtin_amdgcn_rcpf(1.0f + __expf(-aA[nt][j])); }
            const float p0 = lw[0], p1 = p0 + lw[1], p2 = p1 + lw[2], p3 = p2 + lw[3];
            const unsigned s_ = __builtin_bit_cast(unsigned, p3);
            auto s16 = __builtin_amdgcn_permlane16_swap(s_, s_, false, false);
            const float A_ = __builtin_bit_cast(float, (unsigned)s16[0]), pr = A_ + __builtin_bit_cast(float, (unsigned)s16[1]);
            const unsigned pr_ = __builtin_bit_cast(unsigned, pr);
            auto s32 = __builtin_amdgcn_permlane32_swap(pr_, pr_, false, false);
            const float C_ = __builtin_bit_cast(float, (unsigned)s32[0]), tot = C_ + __builtin_bit_cast(float, (unsigned)s32[1]);
            const float base = cumc[nt] + ((q & 1) ? A_ : 0.f) + ((q & 2) ? C_ : 0.f);
            cum[nt] = (f32x4_t){base + p0, base + p1, base + p2, base + p3}; lw0[nt] = lw[0];
            cumc[nt] += tot;
        }
        const LAS unsigned char* xr = (const LAS unsigned char*)xb + (4 * q) * ROWB + ch0 * 2;
        u32x2 rp2 = *(const LAS u32x2*)(xr), kp2 = *(const LAS u32x2*)(xr + 1024), vp2 = *(const LAS u32x2*)(xr + 2048);
        if (q == 0 && (t0 % SEQ) == 0) { rp2 = (u32x2){0u, 0u}; kp2 = (u32x2){0u, 0u}; vp2 = (u32x2){0u, 0u}; }
        const f32x4_t mu_r = *(const LAS f32x4_t*)(cA + ch0), mu_k = *(const LAS f32x4_t*)(cA + 512 + ch0), mu_v = *(const LAS f32x4_t*)(cA + 1024 + ch0);
        const f32x4_t kkc = *(const LAS f32x4_t*)(cB + ch0), kac = *(const LAS f32x4_t*)(cB + 512 + ch0), rkc = *(const LAS f32x4_t*)(cB + 1024 + ch0);
#define PX_EL(w2_, nt_) (((nt_) & 1) ? bfhi((w2_)[(nt_) >> 1]) : bflo((w2_)[(nt_) >> 1]))
#pragma unroll
        for (int j = 0; j < 4; ++j) {
            const int t = t0 + 4 * q + j;
            const u32x2 rc2 = *(const LAS u32x2*)(xr + (j + 1) * ROWB), kc2 = *(const LAS u32x2*)(xr + (j + 1) * ROWB + 1024), vc2 = *(const LAS u32x2*)(xr + (j + 1) * ROWB + 2048);
            float r_[4], k2_[4], kk_[4], v_[4]; float ss = 0.f, bs = 0.f;
#pragma unroll
            for (int nt = 0; nt < 4; ++nt) {
                const float rc_ = PX_EL(rc2, nt), rp_ = PX_EL(rp2, nt), kc_ = PX_EL(kc2, nt), kp_ = PX_EL(kp2, nt), vc_ = PX_EL(vc2, nt), vp_ = PX_EL(vp2, nt);
                const float r = rc_ + (rp_ - rc_) * mu_r[nt], k = kc_ + (kp_ - kc_) * mu_k[nt]; v_[nt] = vc_ + (vp_ - vc_) * mu_v[nt];
                const float kk = k * kkc[nt]; ss += kk * kk;
                const float k2 = k * (1.0f + (aA[nt][j] - 1.0f) * kac[nt]); bs += r * k2 * rkc[nt];
                r_[nt] = r; k2_[nt] = k2; kk_[nt] = kk; }
            ss = row16_sum(ss); bs = row16_sum(bs);
            const float rn = __builtin_amdgcn_rsqf(fmaxf(ss, 1e-24f));
            float oKK[4], oBT[4], oKT[4], oRT[4];
#pragma unroll
            for (int nt = 0; nt < 4; ++nt) {
                const float ecur = __expf(cum[nt][j]), einv = __builtin_amdgcn_rcpf(ecur);
                float eprev; if (j == 0) eprev = __expf(cum[nt][0] - lw0[nt]); else eprev = cum[nt][j - 1];
                const float kk = kk_[nt] * rn;
                oKK[nt] = kk * eprev; oBT[nt] = kk * aA[nt][j] * einv; oKT[nt] = k2_[nt] * einv; oRT[nt] = r_[nt] * ecur; cum[nt][j] = ecur; }
            rp2 = rc2; kp2 = kc2; vp2 = vc2;
            const unsigned o = ob + (unsigned)j * 1024u;
            *(u32x2*)((char*)O.KK + o) = (u32x2){rw::cvtpk(oKK[0], oKK[1]), rw::cvtpk(oKK[2], oKK[3])};
            *(u32x2*)((char*)O.BT + o) = (u32x2){rw::cvtpk(oBT[0], oBT[1]), rw::cvtpk(oBT[2], oBT[3])};
            *(u32x2*)((char*)O.KT + o) = (u32x2){rw::cvtpk(oKT[0], oKT[1]), rw::cvtpk(oKT[2], oKT[3])};
            __builtin_nontemporal_store((u32x2){rw::cvtpk(oRT[0], oRT[1]), rw::cvtpk(oRT[2], oRT[3])}, (u32x2*)((char*)O.RT + o));
            *(u32x2*)((char*)O.V + o) = (u32x2){rw::cvtpk(v_[0], v_[1]), rw::cvtpk(v_[2], v_[3])};
            if (cl == 0) O.bonus[(size_t)t * 8 + F.wave] = bs;
        }
#undef PX_EL
        if ((t0 & 63) == 48 && q == 3) *(f32x4_t*)(O.gamC + (size_t)(t0 >> 6) * 512 + ch0) = (f32x4_t){cum[0][3], cum[1][3], cum[2][3], cum[3][3]};
    }
    asm volatile("s_waitcnt vmcnt(0)" ::: "memory");
    __syncthreads();
}
namespace rw {
template <bool NT = false> __device__ __forceinline__ void fill_img_dma(unsigned lds_u, const bf16* g, int lane) {
    const char* src = (const char*)g + (unsigned)((lane >> 2) * 1024 + (lane & 3) * 16);
#pragma unroll
    for (int k = 0; k < 8; ++k) { if (NT) att::glds16_nt(src + (k & 3) * 16384 + (k >> 2) * 64, (unsigned)__builtin_amdgcn_readfirstlane(lds_u + k * 1024)); else att::glds16(src + (k & 3) * 16384 + (k >> 2) * 64, (unsigned)__builtin_amdgcn_readfirstlane(lds_u + k * 1024)); }
}
__device__ __forceinline__ bf16x8 img_row_frag(lds_cptr img, int rt, int s, int lane) {
    return *(const __attribute__((address_space(3))) bf16x8*)(img + (s >> 1) * 4096 + (s & 1) * 32 + (lane >> 5) * 16 + (32 * rt + (lane & 31)) * 64); }
template <bool DRY> __device__ __forceinline__ void r1_chunk(int u, const Bufs& B, lds_ptr lds) {
    int tid = threadIdx.x; asm volatile("" : "+v"(tid));
    const int lane = tid & 63, l31 = lane & 31, hi = lane >> 5;
    const int bh = u >> 6, n = u & 63, b = bh >> 3, h = bh & 7;
    const size_t row0 = (size_t)b * SEQ + n * 64; const int col0 = h * 64;
    const size_t toff = row0 * 512 + col0;
    bf16* KKg = B.KK + toff; const bf16* BTg = B.BT + toff; const bf16* KTg = B.KT + toff; const bf16* Vg = B.V + toff;
    const lds_ptr img0 = lds, img1 = lds + 8192;
    const lds_cptr tr0 = (lds_cptr)img0 + tr_lane_off(lane);
    const unsigned lds_u = (unsigned)(uintptr_t)lds;
    fill_img_dma(lds_u, Vg, lane); fill_img_dma<true>(lds_u + 24576, KKg, lane); fill_img_dma(lds_u + 8192, KTg, lane); fill_img_dma(lds_u + 16384, BTg, lane);
    asm volatile("s_waitcnt vmcnt(0)" ::: "memory");
    bf16x8 kkf[2][4], af[2][4];
#pragma unroll
    for (int rt = 0; rt < 2; ++rt)
#pragma unroll
        for (int s = 0; s < 4; ++s) { kkf[rt][s] = img_row_frag((lds_cptr)lds + 24576, rt, s, lane); af[rt][s] = img_row_frag((lds_cptr)lds + 8192, rt, s, lane); }
    f32x16 x00 = f32x16{}, x01 = f32x16{}, x11 = f32x16{};
#pragma unroll
    for (int s = 0; s < 4; ++s) { x00 = RMFMA(af[0][s], kkf[0][s], x00); x01 = RMFMA(af[0][s], kkf[1][s], x01); x11 = RMFMA(af[1][s], kkf[1][s], x11); }
#pragma unroll
    for (int r = 0; r < 16; ++r) { const bool keep = crow(r, hi) < l31; x00[r] = keep ? x00[r] : 0.f; x11[r] = keep ? x11[r] : 0.f; }
    asm volatile("s_waitcnt lgkmcnt(0)" ::: "memory");
    bf16x8 avf[2][4];
    {
        bf16x8 vf[2][4];
#pragma unroll
        for (int dt = 0; dt < 2; ++dt)
#pragma unroll
            for (int s = 0; s < 4; ++s) vf[dt][s] = tr_frag(tr0, dt, s);
        const bf16x8 p00 = pack8(x00, 0), p01 = pack8(x00, 1), p10 = pack8(x01, 0), p11 = pack8(x01, 1), p12 = pack8(x11, 0), p13 = pack8(x11, 1);
#pragma unroll
        for (int dt = 0; dt < 2; ++dt) {
            f32x16 a0 = f32x16{}, a1 = f32x16{};
            a0 = RMFMA(p00, vf[dt][0], a0); a0 = RMFMA(p01, vf[dt][1], a0);
            a1 = RMFMA(p10, vf[dt][0], a1); a1 = RMFMA(p11, vf[dt][1], a1); a1 = RMFMA(p12, vf[dt][2], a1); a1 = RMFMA(p13, vf[dt][3], a1);
            avf[dt][0] = pack8(a0, 0); avf[dt][1] = pack8(a0, 1); avf[dt][2] = pack8(a1, 0); avf[dt][3] = pack8(a1, 1);
        }
    }
#pragma unroll
    for (int rt = 0; rt < 2; ++rt)
#pragma unroll
        for (int s = 0; s < 4; ++s) af[rt][s] = img_row_frag((lds_cptr)lds + 16384, rt, s, lane);
    x00 = f32x16{}; x01 = f32x16{}; x11 = f32x16{};
#pragma unroll
    for (int s = 0; s < 4; ++s) { x00 = RMFMA(af[0][s], kkf[0][s], x00); x01 = RMFMA(af[0][s], kkf[1][s], x01); x11 = RMFMA(af[1][s], kkf[1][s], x11); }
    {
        __attribute__((address_space(3))) float* L = (__attribute__((address_space(3))) float*)img1;
#pragma unroll
        for (int q = 0; q < 4; ++q) {
            *(__attribute__((address_space(3))) f32x4*)(L + (l31) * 64 + 8 * q + 4 * hi) = (f32x4){x00[4 * q], x00[4 * q + 1], x00[4 * q + 2], x00[4 * q + 3]};
            *(__attribute__((address_space(3))) f32x4*)(L + (32 + l31) * 64 + 8 * q + 4 * hi) = (f32x4){x01[4 * q], x01[4 * q + 1], x01[4 * q + 2], x01[4 * q + 3]};
            *(__attribute__((address_space(3))) f32x4*)(L + (32 + l31) * 64 + 32 + 8 * q + 4 * hi) = (f32x4){x11[4 * q], x11[4 * q + 1], x11[4 * q + 2], x11[4 * q + 3]};
        }
    }
    asm volatile("s_waitcnt lgkmcnt(0)" ::: "memory");
    __builtin_amdgcn_sched_barrier(0);
    float y[64];
#pragma unroll
    for (int i = 0; i < 64; ++i) y[i] = (i == lane) ? 1.f : 0.f;
    {
        const __attribute__((address_space(3))) float* L = (const __attribute__((address_space(3))) float*)img1;
#pragma unroll
        for (int j = 63; j >= 1; --j) {
#pragma unroll
            for (int i4 = 0; i4 < j; i4 += 4) { const f32x4 a = *(const __attribute__((address_space(3))) f32x4*)(L + j * 64 + i4);
                y[i4] -= y[j] * a[0]; if (i4 + 1 < j) y[i4 + 1] -= y[j] * a[1]; if (i4 + 2 < j) y[i4 + 2] -= y[j] * a[2]; if (i4 + 3 < j) y[i4 + 3] -= y[j] * a[3];
                if ((i4 & 12) == 12) asm volatile("" ::: "memory"); }
            asm volatile("" ::: "memory");
        }
    }
    bf16x8 tn[2][4];
#pragma unroll
    for (int s = 0; s < 4; ++s) {
        unsigned wa[4], wb[4];
#pragma unroll
        for (int jj = 0; jj < 4; ++jj) { const int j = 2 * jj, i0 = 16 * s + 8 * (j >> 2) + (j & 3);
            const unsigned a = cvtpk(-y[i0], -y[i0 + 1]), bq = cvtpk(-y[i0 + 4], -y[i0 + 5]);
            auto rr = __builtin_amdgcn_permlane32_swap(a, bq, false, false); wa[jj] = rr[0]; wb[jj] = rr[1]; }
        tn[0][s] = __builtin_bit_cast(bf16x8, (u32x4){wa[0], wa[1], wa[2], wa[3]}); tn[1][s] = __builtin_bit_cast(bf16x8, (u32x4){wb[0], wb[1], wb[2], wb[3]});
    }
    int tid2 = threadIdx.x; asm volatile("" : "+v"(tid2));
#define lane (tid2 & 63)
#define l31 (tid2 & 31)
#define hi ((tid2 >> 5) & 1)
    asm volatile("s_waitcnt lgkmcnt(0)" ::: "memory");
    fill_img_dma((unsigned)(uintptr_t)lds + 8192, BTg, lane);
    const lds_cptr tr0b = (lds_cptr)img0 + tr_lane_off(lane);
    bf16x8 u0f[2][4];
    {
        unsigned* ud = B.U0d + (size_t)u * 2048;
#pragma unroll
        for (int dt = 0; dt < 2; ++dt) { f32x16 a0 = f32x16{}, a1 = f32x16{};
            a0 = RMFMA(tn[0][0], avf[dt][0], a0); a0 = RMFMA(tn[0][1], avf[dt][1], a0);
#pragma unroll
            for (int s = 0; s < 4; ++s) a1 = RMFMA(tn[1][s], avf[dt][s], a1);
#pragma unroll
            for (int r2 = 0; r2 < 8; ++r2) { __builtin_nontemporal_store(cvtpk(a0[2 * r2], a0[2 * r2 + 1]), (unsigned*)((char*)ud + (unsigned)((((0 * 2 + dt) * 8 + r2) * 64 + lane) * 4))); __builtin_nontemporal_store(cvtpk(a1[2 * r2], a1[2 * r2 + 1]), (unsigned*)((char*)ud + (unsigned)((((1 * 2 + dt) * 8 + r2) * 64 + lane) * 4))); }
            u0f[dt][0] = pack8(a0, 0); u0f[dt][1] = pack8(a0, 1); u0f[dt][2] = pack8(a1, 0); u0f[dt][3] = pack8(a1, 1); }
    }
    const lds_ptr img2 = lds + 24576;
    const lds_cptr trk = (lds_cptr)img2 + tr_lane_off(lane);
    bf16x8 nwa[2][4];
#pragma unroll
    for (int ct = 0; ct < 2; ++ct) { f32x16 a0 = f32x16{}, a1 = f32x16{};
        bf16x8 kb[4];
#pragma unroll
        for (int s = 0; s < 4; ++s) kb[s] = tr_frag(trk, ct, s);
        a0 = RMFMA(tn[0][0], kb[0], a0); a0 = RMFMA(tn[0][1], kb[1], a0);
#pragma unroll
        for (int s = 0; s < 4; ++s) a1 = RMFMA(tn[1][s], kb[s], a1);
        {
            __attribute__((address_space(3))) unsigned short* sg = (__attribute__((address_space(3))) unsigned short*)(lds + 16384) + 32 * ct + l31;
#pragma unroll
            for (int r = 0; r < 16; ++r) { sg[crow(r, hi) * 64] = (unsigned short)(cvtpk(a0[r], 0.f) & 0xffffu); sg[(32 + crow(r, hi)) * 64] = (unsigned short)(cvtpk(a1[r], 0.f) & 0xffffu); } }
        nwa[ct][0] = pack8(a0, 0); nwa[ct][1] = pack8(a0, 1); nwa[ct][2] = pack8(a1, 0); nwa[ct][3] = pack8(a1, 1); }
    asm volatile("s_waitcnt lgkmcnt(0)" ::: "memory");
    {
        bf16* gp = KKg + (size_t)(lane >> 3) * 512 + (lane & 7) * 8; lds_cptr sp = (lds_cptr)lds + 16384 + (lane >> 3) * 128 + (lane & 7) * 16;
#pragma unroll
        for (int it = 0; it < 8; ++it) { const u32x4 w_ = *(const __attribute__((address_space(3))) u32x4*)(sp + it * 1024); if (!DRY) __builtin_nontemporal_store(w_, (u32x4*)gp); else asm volatile("" :: "v"(w_)); gp += 8 * 512; asm volatile("" : "+v"(gp)); }
    }
    asm volatile("s_waitcnt lgkmcnt(0)" ::: "memory");
    fill_img_dma((unsigned)(uintptr_t)lds + 16384, KTg, lane);
    asm volatile("s_waitcnt vmcnt(8)" ::: "memory");
    const lds_cptr tr1 = (lds_cptr)img1 + tr_lane_off(lane);
    bf16x8 bsf[2][4];
#pragma unroll
    for (int ct = 0; ct < 2; ++ct)
#pragma unroll
        for (int s = 0; s < 4; ++s) bsf[ct][s] = tr_frag(tr1, ct, s);
    {
        const float gC0 = B.gamC[(row0 >> 6) * 512 + col0 + l31], gC1 = B.gamC[(row0 >> 6) * 512 + col0 + 32 + l31];
        unsigned char* r2d = (unsigned char*)B.McT + (size_t)u * 16384;
        f32x16 m[2][2];
#pragma unroll
        for (int cpt = 0; cpt < 2; ++cpt)
#pragma unroll
            for (int ct = 0; ct < 2; ++ct) {
                f32x16 mm = f32x16{};
#pragma unroll
                for (int s = 0; s < 4; ++s) mm = RMFMA(nwa[cpt][s], bsf[ct][s], mm);
                const float gc = ct ? gC1 : gC0;
#pragma unroll
                for (int r = 0; r < 16; ++r) { float v = mm[r]; if (cpt == ct) v += (crow(r, hi) == l31) ? 1.f : 0.f; mm[r] = v * gc; }
                m[cpt][ct] = mm;
            }
#pragma unroll
        for (int ct = 0; ct < 2; ++ct)
#pragma unroll
            for (int s = 0; s < 4; ++s) *(bf16x8*)(r2d + (unsigned)(((ct * 4 + s) * 64 + lane) * 16)) = pack8(m[s >> 1][ct], s & 1);
    }
    asm volatile("s_waitcnt vmcnt(0)" ::: "memory");
    {
        const lds_cptr tr2 = tr1 + 8192;
        unsigned char* gd = (unsigned char*)B.McT + (size_t)u * 16384 + 8192;
        const float* gcv = B.gamC + (row0 >> 6) * 512 + col0;
#pragma unroll
        for (int ct = 0; ct < 2; ++ct) {
            bf16x8 ka[4];
#pragma unroll
            for (int s = 0; s < 4; ++s) ka[s] = tr_frag(tr2, ct, s);
#pragma unroll
            for (int dt = 0; dt < 2; ++dt) {
                f32x16 g = f32x16{};
#pragma unroll
                for (int s = 0; s < 4; ++s) { g = RMFMA(bsf[ct][s], u0f[dt][s], g); g = RMFMA(ka[s], tr_frag(tr0b, dt, s), g); }
#pragma unroll
                for (int r = 0; r < 16; ++r) g[r] *= gcv[32 * ct + crow(r, hi)];
                *(u32x4*)(gd + (unsigned)((((dt * 2 + ct) * 2 + 0) * 64 + lane) * 16)) = (u32x4){cvtpk(g[0], g[1]), cvtpk(g[2], g[3]), cvtpk(g[4], g[5]), cvtpk(g[6], g[7])};
                *(u32x4*)(gd + (unsigned)((((dt * 2 + ct) * 2 + 1) * 64 + lane) * 16)) = (u32x4){cvtpk(g[8], g[9]), cvtpk(g[10], g[11]), cvtpk(g[12], g[13]), cvtpk(g[14], g[15])};
            }
        }
    }
    asm volatile("s_waitcnt lgkmcnt(0)" ::: "memory");
#undef lane
#undef l31
#undef hi
}
}
namespace rw {
struct R2Set { bf16x8 m[2][4]; u32x4 g[2][2]; };
__device__ __forceinline__ void r2_load(R2Set& S, const unsigned char* blk, int dt, int lane) {
#pragma unroll
    for (int ct = 0; ct < 2; ++ct) {
#pragma unroll
        for (int s = 0; s < 4; ++s) S.m[ct][s] = *(const bf16x8*)(blk + (unsigned)(((ct * 4 + s) * 64 + lane) * 16));
#pragma unroll
        for (int hf = 0; hf < 2; ++hf) S.g[ct][hf] = *(const u32x4*)(blk + 8192 + (unsigned)((((dt * 2 + ct) * 2 + hf) * 64 + lane) * 16)); }
}
__device__ __forceinline__ f32x16 r2_unpack(const u32x4& a, const u32x4& b) {
    f32x16 x; x[0] = bflo(a.x); x[1] = bfhi(a.x); x[2] = bflo(a.y); x[3] = bfhi(a.y); x[4] = bflo(a.z); x[5] = bfhi(a.z); x[6] = bflo(a.w); x[7] = bfhi(a.w);
    x[8] = bflo(b.x); x[9] = bfhi(b.x); x[10] = bflo(b.y); x[11] = bfhi(b.y); x[12] = bflo(b.z); x[13] = bfhi(b.z); x[14] = bflo(b.w); x[15] = bfhi(b.w); return x; }
__device__ __forceinline__ void r2_step(const R2Set& S, f32x16& st0, f32x16& st1, bf16* s0row, int hi) {
#pragma unroll
    for (int q = 0; q < 4; ++q) { *(u32x2*)(s0row + 8 * q + 4 * hi) = (u32x2){cvtpk(st0[4 * q], st0[4 * q + 1]), cvtpk(st0[4 * q + 2], st0[4 * q + 3])};
        *(u32x2*)(s0row + 32 + 8 * q + 4 * hi) = (u32x2){cvtpk(st1[4 * q], st1[4 * q + 1]), cvtpk(st1[4 * q + 2], st1[4 * q + 3])}; }
    const bf16x8 x0 = pack8(st0, 0), x1 = pack8(st0, 1), x2 = pack8(st1, 0), x3 = pack8(st1, 1);
    f32x16 n0 = r2_unpack(S.g[0][0], S.g[0][1]), n1 = r2_unpack(S.g[1][0], S.g[1][1]);
    n0 = RMFMA(S.m[0][0], x0, n0); n1 = RMFMA(S.m[1][0], x0, n1); n0 = RMFMA(S.m[0][1], x1, n0); n1 = RMFMA(S.m[1][1], x1, n1);
    n0 = RMFMA(S.m[0][2], x2, n0); n1 = RMFMA(S.m[1][2], x2, n1); n0 = RMFMA(S.m[0][3], x3, n0); n1 = RMFMA(S.m[1][3], x3, n1);
    st0 = n0; st1 = n1;
}
__device__ __forceinline__ void r2_chain(int bh, int dt, const Bufs& B) {
    int tid = threadIdx.x; asm volatile("" : "+v"(tid));
    const int lane = tid & 63, l31 = lane & 31, hi = lane >> 5;
    f32x16 st0 = f32x16{}, st1 = f32x16{};
    const unsigned char* blk = (const unsigned char*)B.McT + (size_t)bh * 64 * 16384;
    bf16* s0p = B.S0 + (size_t)bh * 64 * 4096 + (size_t)(32 * dt + l31) * 64;
    R2Set A, Bq, C;
    r2_load(A, blk, dt, lane); r2_load(Bq, blk + 16384, dt, lane); r2_load(C, blk + 2 * 16384, dt, lane);
    for (int n = 0; n < 63; n += 3) {
        r2_step(A, st0, st1, s0p + (size_t)n * 4096, hi);        if (n + 3 < 64) r2_load(A, blk + (size_t)(n + 3) * 16384, dt, lane);
        r2_step(Bq, st0, st1, s0p + (size_t)(n + 1) * 4096, hi); if (n + 4 < 64) r2_load(Bq, blk + (size_t)(n + 4) * 16384, dt, lane);
        r2_step(C, st0, st1, s0p + (size_t)(n + 2) * 4096, hi);  if (n + 5 < 64) r2_load(C, blk + (size_t)(n + 5) * 16384, dt, lane);
    }
    r2_step(A, st0, st1, s0p + (size_t)63 * 4096, hi);
}

__device__ __forceinline__ void r2_chain_dma(int bh, int dt, const Bufs& B, lds_ptr lds) {
    int tid = threadIdx.x; asm volatile("" : "+v"(tid));
    const int lane = tid & 63, l31 = lane & 31, hi = lane >> 5;
    const unsigned lds0 = (unsigned)(uintptr_t)lds;
    const unsigned char* blk = (const unsigned char*)B.McT + (size_t)bh * 64 * 16384 + lane * 16;
    unsigned char* s0g = (unsigned char*)B.S0 + (size_t)bh * 64 * 8192 + dt * 4096 + lane * 16;
#define R2D_ISSUE(g_) do { _Pragma("unroll") for (int s_ = 0; s_ < 4; ++s_) { const unsigned char* src_ = blk + (size_t)(4 * (g_) + s_) * 16384; const unsigned base_ = lds0 + ((g_) & 1) * 49152 + s_ * 12288; \
        _Pragma("unroll") for (int i_ = 0; i_ < 8; ++i_) att::glds16(src_ + i_ * 1024, (unsigned)__builtin_amdgcn_readfirstlane(base_ + i_ * 1024)); \
        _Pragma("unroll") for (int i_ = 0; i_ < 4; ++i_) att::glds16(src_ + 8192 + dt * 4096 + i_ * 1024, (unsigned)__builtin_amdgcn_readfirstlane(base_ + 8192 + i_ * 1024)); } } while (0)
    f32x16 st0 = f32x16{}, st1 = f32x16{};
    R2D_ISSUE(0);
    asm volatile("s_waitcnt vmcnt(0)" ::: "memory");
    for (int g = 0; g < 16; ++g) {
        if (g + 1 < 16) R2D_ISSUE(g + 1);
#pragma unroll
        for (int s = 0; s < 4; ++s) {
            const lds_cptr slot = (lds_cptr)lds + (g & 1) * 49152 + s * 12288 + lane * 16;
            const lds_ptr stg = lds + 98304 + s * 4096 + l31 * 128 + 8 * hi;
#pragma unroll
            for (int q = 0; q < 4; ++q) { *(__attribute__((address_space(3))) u32x2*)(stg + 16 * q) = (u32x2){cvtpk(st0[4 * q], st0[4 * q + 1]), cvtpk(st0[4 * q + 2], st0[4 * q + 3])};
                *(__attribute__((address_space(3))) u32x2*)(stg + 64 + 16 * q) = (u32x2){cvtpk(st1[4 * q], st1[4 * q + 1]), cvtpk(st1[4 * q + 2], st1[4 * q + 3])}; }
            R2Set S;
#pragma unroll
            for (int ct = 0; ct < 2; ++ct) {
#pragma unroll
                for (int k = 0; k < 4; ++k) S.m[ct][k] = *(const __attribute__((address_space(3))) bf16x8*)(slot + (ct * 4 + k) * 1024);
#pragma unroll
                for (int hf = 0; hf < 2; ++hf) S.g[ct][hf] = *(const __attribute__((address_space(3))) u32x4*)(slot + 8192 + (ct * 2 + hf) * 1024); }
            const bf16x8 x0 = pack8(st0, 0), x1 = pack8(st0, 1), x2 = pack8(st1, 0), x3 = pack8(st1, 1);
            f32x16 n0 = r2_unpack(S.g[0][0], S.g[0][1]), n1 = r2_unpack(S.g[1][0], S.g[1][1]);
            n0 = RMFMA(S.m[0][0], x0, n0); n1 = RMFMA(S.m[1][0], x0, n1); n0 = RMFMA(S.m[0][1], x1, n0); n1 = RMFMA(S.m[1][1], x1, n1);
            n0 = RMFMA(S.m[0][2], x2, n0); n1 = RMFMA(S.m[1][2], x2, n1); n0 = RMFMA(S.m[0][3], x3, n0); n1 = RMFMA(S.m[1][3], x3, n1);
            st0 = n0; st1 = n1;
        }
        asm volatile("s_waitcnt lgkmcnt(0)" ::: "memory");
#pragma unroll
        for (int s = 0; s < 4; ++s)
#pragma unroll
            for (int i = 0; i < 4; ++i) *(u32x4*)(s0g + (size_t)(4 * g + s) * 8192 + i * 1024) = *(const __attribute__((address_space(3))) u32x4*)((lds_cptr)lds + 98304 + s * 4096 + i * 1024 + lane * 16);
        asm volatile("s_waitcnt vmcnt(0) lgkmcnt(0)" ::: "memory");
    }
#undef R2D_ISSUE
}

__device__ __forceinline__ void r2_chain_wg(int bh, int dt, const Bufs& B, lds_ptr lds, int wave) {
    int tid = threadIdx.x; asm volatile("" : "+v"(tid));
    const int lane = tid & 63, l31 = lane & 31, hi = lane >> 5;
    const unsigned lds0 = (unsigned)(uintptr_t)lds;
    const unsigned char* blk = (const unsigned char*)B.McT + (size_t)bh * 64 * 16384 + lane * 16;
    unsigned char* s0g = (unsigned char*)B.S0 + (size_t)bh * 64 * 8192 + dt * 4096 + lane * 16;
    const bool loader = (wave >= 1 && wave <= 4);
#define R2W_DMA(g_) do { _Pragma("unroll") for (int k_ = 0; k_ < 6; ++k_) { const int q_ = (wave - 1) * 6 + k_, s_ = q_ / 12, j_ = q_ - 12 * s_; \
        const unsigned char* src_ = blk + (size_t)(2 * (g_) + s_) * 16384 + (j_ < 8 ? j_ * 1024 : 8192 + dt * 4096 + (j_ - 8) * 1024); \
        if (j_ < 8) att::glds16(src_, (unsigned)__builtin_amdgcn_readfirstlane(lds0 + ((g_) & 3) * 24576 + s_ * 12288 + j_ * 1024)); \
        else att::glds16_nt(src_, (unsigned)__builtin_amdgcn_readfirstlane(lds0 + ((g_) & 3) * 24576 + s_ * 12288 + j_ * 1024)); } } while (0)
#define R2W_ST(g_) do { _Pragma("unroll") for (int k_ = 0; k_ < 2; ++k_) { const int id_ = (wave - 1) * 2 + k_, s_ = id_ >> 2, i_ = id_ & 3; \
        *(u32x4*)(s0g + (size_t)(2 * (g_) + s_) * 8192 + i_ * 1024) = *(const __attribute__((address_space(3))) u32x4*)((lds_cptr)lds + 98304 + ((g_) & 1) * 8192 + s_ * 4096 + i_ * 1024 + lane * 16); } } while (0)
    f32x16 st0 = f32x16{}, st1 = f32x16{};
    if (loader) { R2W_DMA(0); R2W_DMA(1); R2W_DMA(2); asm volatile("s_waitcnt vmcnt(12)" ::: "memory"); }
    for (int g = 0; g < 32; ++g) {
        __syncthreads();
        if (wave == 0) {
#pragma unroll
            for (int s = 0; s < 2; ++s) {
                const lds_cptr slot = (lds_cptr)lds + (g & 3) * 24576 + s * 12288 + lane * 16;
                const lds_ptr stg = lds + 98304 + (g & 1) * 8192 + s * 4096 + l31 * 128 + 8 * hi;
#pragma unroll
                for (int q = 0; q < 4; ++q) { *(__attribute__((address_space(3))) u32x2*)(stg + 16 * q) = (u32x2){cvtpk(st0[4 * q], st0[4 * q + 1]), cvtpk(st0[4 * q + 2], st0[4 * q + 3])};
                    *(__attribute__((address_space(3))) u32x2*)(stg + 64 + 16 * q) = (u32x2){cvtpk(st1[4 * q], st1[4 * q + 1]), cvtpk(st1[4 * q + 2], st1[4 * q + 3])}; }
                R2Set S;
#pragma unroll
                for (int ct = 0; ct < 2; ++ct) {
#pragma unroll
                    for (int k = 0; k < 4; ++k) S.m[ct][k] = *(const __attribute__((address_space(3))) bf16x8*)(slot + (ct * 4 + k) * 1024);
#pragma unroll
                    for (int hf = 0; hf < 2; ++hf) S.g[ct][hf] = *(const __attribute__((address_space(3))) u32x4*)(slot + 8192 + (ct * 2 + hf) * 1024); }
                const bf16x8 x0 = pack8(st0, 0), x1 = pack8(st0, 1), x2 = pack8(st1, 0), x3 = pack8(st1, 1);
                f32x16 n0 = r2_unpack(S.g[0][0], S.g[0][1]), n1 = r2_unpack(S.g[1][0], S.g[1][1]);
                n0 = RMFMA(S.m[0][0], x0, n0); n1 = RMFMA(S.m[1][0], x0, n1); n0 = RMFMA(S.m[0][1], x1, n0); n1 = RMFMA(S.m[1][1], x1, n1);
                n0 = RMFMA(S.m[0][2], x2, n0); n1 = RMFMA(S.m[1][2], x2, n1); n0 = RMFMA(S.m[0][3], x3, n0); n1 = RMFMA(S.m[1][3], x3, n1);
                st0 = n0; st1 = n1;
            }
            asm volatile("s_waitcnt lgkmcnt(0)" ::: "memory");
        } else if (loader) {
            if (g + 3 < 32) R2W_DMA(g + 3);
            if (g >= 1) R2W_ST(g - 1);
            if (g >= 3 && g <= 28) asm volatile("s_waitcnt vmcnt(18)" ::: "memory");
            else if (g == 0) asm volatile("s_waitcnt vmcnt(12)" ::: "memory");
            else if (g == 1) asm volatile("s_waitcnt vmcnt(14)" ::: "memory");
            else if (g == 2) asm volatile("s_waitcnt vmcnt(16)" ::: "memory");
            else if (g == 29) asm volatile("s_waitcnt vmcnt(12)" ::: "memory");
            else asm volatile("s_waitcnt vmcnt(6)" ::: "memory");
        }
    }
    __syncthreads();
    if (loader) { R2W_ST(31); asm volatile("s_waitcnt vmcnt(0)" ::: "memory"); }
#undef R2W_DMA
#undef R2W_ST
}
__device__ __forceinline__ void r3_chunk(int u, const Bufs& B, const float* ln_g, const float* ln_b, bf16* mix, lds_ptr lds) {
    int tid = threadIdx.x; asm volatile("" : "+v"(tid));
    const int lane = tid & 63, l31 = lane & 31, hi = lane >> 5;
    const int bh = u >> 6, n = u & 63, b = bh >> 3, h = bh & 7;
    const size_t row0 = (size_t)b * SEQ + n * 64; const int col0 = h * 64;
    const size_t toff = row0 * 512 + col0;
    const bf16* NWg = B.KK + toff; const bf16* BTg = B.BT + toff; const bf16* KTg = B.KT + toff; const bf16* RTg = B.RT + toff; const bf16* Vg = B.V + toff; const bf16* Gg = B.G + toff;
    const bf16* S0g = B.S0 + (size_t)u * 4096;
    fill_img(lds, Vg, lane);
    bf16x8 s0f[2][4];
#pragma unroll
    for (int dt = 0; dt < 2; ++dt)
#pragma unroll
        for (int s = 0; s < 4; ++s) s0f[dt][s] = *(const bf16x8*)(S0g + (size_t)(32 * dt + l31) * 64 + 16 * s + 8 * hi);
    bf16x8 uf[2][4];
    bf16x8 rf[2][4], abt[2][4], akt[2][4];
    {
        bf16x8 nwf[2][4];
#pragma unroll
        for (int it = 0; it < 2; ++it)
#pragma unroll
            for (int s = 0; s < 4; ++s) nwf[it][s] = row_frag(NWg, it, s, lane);
        const unsigned* ud = B.U0d + (size_t)u * 2048;
        unsigned uw[2][2][8];
#pragma unroll
        for (int dt = 0; dt < 2; ++dt)
#pragma unroll
            for (int r2 = 0; r2 < 8; ++r2) { uw[dt][0][r2] = __builtin_nontemporal_load(ud + ((0 * 2 + dt) * 8 + r2) * 64 + lane); uw[dt][1][r2] = __builtin_nontemporal_load(ud + ((1 * 2 + dt) * 8 + r2) * 64 + lane); }
#pragma unroll
        for (int tt = 0; tt < 2; ++tt)
#pragma unroll
            for (int s = 0; s < 4; ++s) { rf[tt][s] = row_frag(RTg, tt, s, lane); abt[tt][s] = row_frag(BTg, tt, s, lane); }
#pragma unroll
        for (int dt = 0; dt < 2; ++dt) {
            f32x16 a0, a1;
#pragma unroll
            for (int r2 = 0; r2 < 8; ++r2) { const unsigned w0 = uw[dt][0][r2], w1 = uw[dt][1][r2];
                a0[2 * r2] = bflo(w0); a0[2 * r2 + 1] = bfhi(w0); a1[2 * r2] = bflo(w1); a1[2 * r2 + 1] = bfhi(w1); }
#pragma unroll
            for (int s = 0; s < 4; ++s) { a0 = RMFMA(nwf[0][s], s0f[dt][s], a0); a1 = RMFMA(nwf[1][s], s0f[dt][s], a1); }
            uf[dt][0] = pack8(a0, 0); uf[dt][1] = pack8(a0, 1); uf[dt][2] = pack8(a1, 0); uf[dt][3] = pack8(a1, 1);
        }
    }
#pragma unroll
    for (int tt = 0; tt < 2; ++tt)
#pragma unroll
        for (int s = 0; s < 4; ++s) akt[tt][s] = row_frag(KTg, tt, s, lane);
    f32x16 o[2][2];
#pragma unroll
    for (int tt = 0; tt < 2; ++tt)
#pragma unroll
        for (int dt = 0; dt < 2; ++dt) { o[tt][dt] = f32x16{};
#pragma unroll
            for (int s = 0; s < 4; ++s) o[tt][dt] = RMFMA(rf[tt][s], s0f[dt][s], o[tt][dt]); }
    asm volatile("s_waitcnt lgkmcnt(0)" ::: "memory");
    const lds_cptr tr0 = (lds_cptr)lds + tr_lane_off(lane);
#pragma unroll
    for (int pass = 0; pass < 2; ++pass) {
        f32x16 x00 = f32x16{}, x01 = f32x16{}, x11 = f32x16{};
#pragma unroll
        for (int s = 0; s < 4; ++s) { const bf16x8 a0 = pass ? akt[0][s] : abt[0][s], a1 = pass ? akt[1][s] : abt[1][s];
            x00 = RMFMA(a0, rf[0][s], x00); x01 = RMFMA(a0, rf[1][s], x01); x11 = RMFMA(a1, rf[1][s], x11); }
#pragma unroll
        for (int r = 0; r < 16; ++r) { const bool keep = crow(r, hi) <= l31; x00[r] = keep ? x00[r] : 0.f; x11[r] = keep ? x11[r] : 0.f; }
        const bf16x8 p00 = pack8(x00, 0), p01 = pack8(x00, 1), p10 = pack8(x01, 0), p11 = pack8(x01, 1), p12 = pack8(x11, 0), p13 = pack8(x11, 1);
#pragma unroll
        for (int dt = 0; dt < 2; ++dt) {
            bf16x8 bb[4];
#pragma unroll
            for (int s = 0; s < 4; ++s) bb[s] = pass ? tr_frag(tr0, dt, s) : uf[dt][s];
            o[0][dt] = RMFMA(p00, bb[0], o[0][dt]); o[0][dt] = RMFMA(p01, bb[1], o[0][dt]);
            o[1][dt] = RMFMA(p10, bb[0], o[1][dt]); o[1][dt] = RMFMA(p11, bb[1], o[1][dt]); o[1][dt] = RMFMA(p12, bb[2], o[1][dt]); o[1][dt] = RMFMA(p13, bb[3], o[1][dt]);
        }
    }
    u32x4 vwp[8], gwp[8]; float bonp[8];
#pragma unroll
    for (int i = 0; i < 8; ++i) { const int t = i * 8 + (lane >> 3); bonp[i] = B.bonus[(row0 + t) * 8 + h];
        vwp[i] = __builtin_nontemporal_load((const u32x4*)(Vg + (size_t)t * 512 + (lane & 7) * 8)); gwp[i] = __builtin_nontemporal_load((const u32x4*)(Gg + (size_t)t * 512 + (lane & 7) * 8)); }
    __attribute__((address_space(3))) float* stg = (__attribute__((address_space(3))) float*)(lds + 8192);
#pragma unroll
    for (int tt = 0; tt < 2; ++tt)
#pragma unroll
        for (int dt = 0; dt < 2; ++dt)
#pragma unroll
            for (int r = 0; r < 16; ++r) stg[(32 * tt + crow(r, hi)) * 64 + 32 * dt + l31] = o[tt][dt][r];
    asm volatile("s_waitcnt lgkmcnt(0)" ::: "memory");
    const int ch = lane & 7;
    const f32x4 lg0 = *(const f32x4*)(ln_g + col0 + ch * 8), lg1 = *(const f32x4*)(ln_g + col0 + ch * 8 + 4), lb0 = *(const f32x4*)(ln_b + col0 + ch * 8), lb1 = *(const f32x4*)(ln_b + col0 + ch * 8 + 4);
#pragma unroll
    for (int i = 0; i < 8; ++i) { const int t = i * 8 + (lane >> 3);
        const f32x4 a = *(const __attribute__((address_space(3))) f32x4*)(stg + t * 64 + ch * 8), c = *(const __attribute__((address_space(3))) f32x4*)(stg + t * 64 + ch * 8 + 4);
        float sm = (a[0] + a[1]) + (a[2] + a[3]) + (c[0] + c[1]) + (c[2] + c[3]);
        sm += __shfl_xor(sm, 1); sm += __shfl_xor(sm, 2); sm += __shfl_xor(sm, 4);
        const float mean = sm * (1.f / 64.f);
        const f32x4 da = a - mean, dc = c - mean;
        float sq = (da[0] * da[0] + da[1] * da[1]) + (da[2] * da[2] + da[3] * da[3]) + (dc[0] * dc[0] + dc[1] * dc[1]) + (dc[2] * dc[2] + dc[3] * dc[3]);
        sq += __shfl_xor(sq, 1); sq += __shfl_xor(sq, 2); sq += __shfl_xor(sq, 4);
        const float rstd = 1.0f / sqrtf(sq * (1.f / 64.f) + GN_EPS);
        const float bon = bonp[i];
        const u32x4 vw = vwp[i], gw = gwp[i];
        float e[8];
        e[0] = (da[0] * rstd * lg0[0] + lb0[0] + bon * bflo(vw.x)) * bflo(gw.x); e[1] = (da[1] * rstd * lg0[1] + lb0[1] + bon * bfhi(vw.x)) * bfhi(gw.x);
        e[2] = (da[2] * rstd * lg0[2] + lb0[2] + bon * bflo(vw.y)) * bflo(gw.y); e[3] = (da[3] * rstd * lg0[3] + lb0[3] + bon * bfhi(vw.y)) * bfhi(gw.y);
        e[4] = (dc[0] * rstd * lg1[0] + lb1[0] + bon * bflo(vw.z)) * bflo(gw.z); e[5] = (dc[1] * rstd * lg1[1] + lb1[1] + bon * bfhi(vw.z)) * bfhi(gw.z);
        e[6] = (dc[2] * rstd * lg1[2] + lb1[2] + bon * bflo(vw.w)) * bflo(gw.w); e[7] = (dc[3] * rstd * lg1[3] + lb1[3] + bon * bfhi(vw.w)) * bfhi(gw.w);
        *(u32x4*)(mix + (row0 + t) * INW_PAD + 512 + col0 + ch * 8) = (u32x4){cvtpk(e[0], e[1]), cvtpk(e[2], e[3]), cvtpk(e[4], e[5]), cvtpk(e[6], e[7])};
    }
    asm volatile("s_waitcnt lgkmcnt(0)" ::: "memory");
}
#undef RMFMA
}
__device__ __forceinline__ float bfly32(float (&a)[32], int lane) {
#pragma unroll
    for (int i = 0; i < 16; ++i) { const bool up = (lane & 32) != 0; const float send = up ? a[i] : a[16 + i], keep = up ? a[16 + i] : a[i]; a[i] = keep + __shfl_xor(send, 32); }
#pragma unroll
    for (int i = 0; i < 8; ++i) { const bool up = (lane & 16) != 0; const float send = up ? a[i] : a[8 + i], keep = up ? a[8 + i] : a[i]; a[i] = keep + __shfl_xor(send, 16); }
#pragma unroll
    for (int i = 0; i < 4; ++i) { const bool up = (lane & 8) != 0; const float send = up ? a[i] : a[4 + i], keep = up ? a[4 + i] : a[i]; a[i] = keep + __shfl_xor(send, 8); }
#pragma unroll
    for (int i = 0; i < 2; ++i) { const bool up = (lane & 4) != 0; const float send = up ? a[i] : a[2 + i], keep = up ? a[2 + i] : a[i]; a[i] = keep + __shfl_xor(send, 4); }
    { const bool up = (lane & 2) != 0; const float send = up ? a[0] : a[1], keep = up ? a[1] : a[0]; a[0] = keep + __shfl_xor(send, 2); }
    return a[0] + __shfl_xor(a[0], 1);
}
typedef float f32x4_r __attribute__((ext_vector_type(4)));
__device__ __forceinline__ unsigned p6_cvt(float lo, float hi) { typedef float f2 __attribute__((ext_vector_type(2))); typedef __bf16 b2 __attribute__((ext_vector_type(2))); f2 v = {lo, hi}; b2 b = __builtin_convertvector(v, b2); return __builtin_bit_cast(unsigned, b); }
__device__ __forceinline__ void p6_router_images(Frame& F, const float* g_ffn, const float* w_router) {
    unsigned char* wh = F.ws + WS_ROUT; unsigned char* wl = wh + 65536;
    for (int i = (F.vcu * NTHREADS + F.tid); i < 1024 * 32; i += F.G * NTHREADS) { const int k = i >> 5, e = i & 31; const float v = w_router[i] * g_ffn[k];
        const unsigned hb = f2bf(v); const float lo = v - __builtin_bit_cast(float, hb << 16); const unsigned lb = f2bf(lo);
        const int chunk = k >> 3, pc = (chunk & ~15) | ((chunk & 15) ^ (e & 15)); const int off = e * 2048 + pc * 16 + (k & 7) * 2;
        *(unsigned short*)(wh + off) = (unsigned short)hb; *(unsigned short*)(wl + off) = (unsigned short)lb; }
}
__device__ __forceinline__ void p6_router(Frame& F, const float* g_ffn, const float* w_router, const float* b_router) {
    LAS unsigned char* wh = F.lds + RING_OFF; LAS unsigned char* wl = wh + 65536;
    volatile LAS int* hist = (volatile LAS int*)(F.lds + LDSCTL_OFF);
    LAS float* wst = (LAS float*)(F.lds + LDSCTL_OFF + 1024) + F.wave * 320;
    {
        const unsigned char* img = F.ws + WS_ROUT + F.lane * 16; const unsigned lds_u = (unsigned)(uintptr_t)wh;
#pragma unroll
        for (int k = 0; k < 16; ++k) att::glds16(img + (k * 8 + F.wave) * 1024, (unsigned)__builtin_amdgcn_readfirstlane(lds_u + (k * 8 + F.wave) * 1024));
    }
    if (F.tid < 32) hist[F.tid] = 0;
    asm volatile("s_waitcnt vmcnt(0)" ::: "memory");
    __syncthreads();
    const bf16* hbuf = (const bf16*)(F.ws + WS_WD); unsigned char* XN2 = (unsigned char*)F.out;
    int* tope = (int*)(F.ws + WS_TAB + TAB_TOPE); float* topg = (float*)(F.ws + WS_TAB + TAB_TOPG);
    const int t0 = F.vcu * 128 + F.wave * 16;
    LAS float* gst = (LAS float*)(F.lds + LDSCTL_OFF + 11264);
    gst[F.tid] = g_ffn[F.tid]; gst[512 + F.tid] = g_ffn[512 + F.tid];
    f32x4_r acc0 = {0.f, 0.f, 0.f, 0.f}, acc1 = {0.f, 0.f, 0.f, 0.f};
    {
        const int r16 = F.lane & 15, h4 = F.lane >> 4;
        const bf16* xrow = hbuf + (size_t)(t0 + r16) * D_MODEL + 8 * h4;
        bf16x8 xf[32];
#pragma unroll
        for (int s = 0; s < 32; ++s) xf[s] = *(const bf16x8*)(xrow + 32 * s);
        __syncthreads();
        const LAS unsigned char* bh0 = wh + r16 * 2048; const LAS unsigned char* bh1 = wh + (16 + r16) * 2048;
        f32x4_r accq = {0.f, 0.f, 0.f, 0.f};
#pragma unroll
        for (int s = 0; s < 32; ++s) {
            const int chunk = 4 * s + h4, pc = ((chunk & ~15) | ((chunk & 15) ^ r16)) * 16;
            const bf16x8 wh0 = *(const LAS bf16x8*)(bh0 + pc), wh1 = *(const LAS bf16x8*)(bh1 + pc), wl0 = *(const LAS bf16x8*)(bh0 + 65536 + pc), wl1 = *(const LAS bf16x8*)(bh1 + 65536 + pc);
            acc0 = __builtin_amdgcn_mfma_f32_16x16x32_bf16(xf[s], wh0, acc0, 0, 0, 0); acc1 = __builtin_amdgcn_mfma_f32_16x16x32_bf16(xf[s], wh1, acc1, 0, 0, 0);
            acc0 = __builtin_amdgcn_mfma_f32_16x16x32_bf16(xf[s], wl0, acc0, 0, 0, 0); acc1 = __builtin_amdgcn_mfma_f32_16x16x32_bf16(xf[s], wl1, acc1, 0, 0, 0);
            accq = __builtin_amdgcn_mfma_f32_16x16x32_bf16(xf[s], xf[s], accq, 0, 0, 0);
            if ((s & 3) == 3) asm volatile("" ::: "memory");
        }
#pragma unroll
        for (int j2 = 0; j2 < 4; ++j2) if (r16 == 4 * h4 + j2) wst[256 + r16] = 1.f / sqrtf(accq[j2] * (1.f / D_MODEL) + NORM_EPS);
        LDS_WAIT(); asm volatile("" ::: "memory");
        const float rs = wst[256 + r16];
        unsigned char* xo = XN2 + (size_t)(t0 + r16) * D_MODEL + 8 * h4;
#pragma unroll
        for (int s = 0; s < 32; ++s) { const v4u w = __builtin_bit_cast(v4u, xf[s]); const f32x4 g0 = *(const LAS f32x4*)(gst + 32 * s + 8 * h4) * rs, g1 = *(const LAS f32x4*)(gst + 32 * s + 8 * h4 + 4) * rs;
            typedef unsigned u32x2_ __attribute__((ext_vector_type(2)));
            *(u32x2_*)(xo + 32 * s) = (u32x2_){pk4_fp8(bflo(w.x) * g0.x, bfhi(w.x) * g0.y, bflo(w.y) * g0.z, bfhi(w.y) * g0.w), pk4_fp8(bflo(w.z) * g1.x, bfhi(w.z) * g1.y, bflo(w.w) * g1.z, bfhi(w.w) * g1.w)}; if ((s & 3) == 3) asm volatile("" ::: "memory"); }
    }
    const float brl = b_router[F.lane >> 1];
#pragma unroll
    for (int half = 0; half < 2; ++half) {
        LDS_WAIT(); asm volatile("" ::: "memory");
        { const int r16 = F.lane & 15, h4 = F.lane >> 4;
          if ((h4 >> 1) == half) {
#pragma unroll
              for (int r = 0; r < 4; ++r) { const int tq = (h4 & 1) * 4 + r; const float rs = wst[256 + half * 8 + tq]; wst[tq * 32 + r16] = acc0[r] * rs; wst[tq * 32 + 16 + r16] = acc1[r] * rs; } } }
        LDS_WAIT(); asm volatile("" ::: "memory");
        for (int q = 0; q < 8; ++q) {
            float lg = wst[q * 32 + (F.lane >> 1)] + brl; int e = F.lane >> 1; asm volatile("" : "+v"(e)); int rank = 0;
#pragma unroll
            for (int j = 0; j < 32; ++j) { const float o = __builtin_bit_cast(float, __builtin_amdgcn_readlane(__builtin_bit_cast(int, lg), 2 * j)); rank += (o > lg || (o == lg && j < e)) ? 1 : 0; }
            const float mx = wave_sum((rank == 0 && (F.lane & 1) == 0) ? lg : 0.f);
            const bool sel = rank < 4 && (F.lane & 1) == 0;
            const float ex = sel ? __expf(lg - mx) : 0.f; const float den = wave_sum(ex);
            if (sel) { const int t = t0 + half * 8 + q; tope[t * 4 + rank] = e; topg[t * 4 + rank] = ex / den; __hip_atomic_fetch_add((LAS int*)hist + e, 1, __ATOMIC_RELAXED, __HIP_MEMORY_SCOPE_WORKGROUP); }
        }
    }
    __syncthreads();
    if (F.tid < 32) ((int*)(F.ws + WS_TAB + TAB_WGCNT))[F.vcu * 32 + F.tid] = hist[F.tid];
}

__device__ __forceinline__ void p7_scatter(Frame& F) {
    volatile LAS int* sh = (volatile LAS int*)(F.lds + RING_OFF);
    const int* wgc = (const int*)(F.ws + WS_TAB + TAB_WGCNT);
    { const int e = F.tid & 31, p = F.tid >> 5; int tot = 0, before = 0;
#pragma unroll
      for (int i = 0; i < 16; ++i) { const int w = 16 * p + i; const int c = wgc[w * 32 + e]; tot += c; before += (w < F.vcu) ? c : 0; }
      sh[256 + p * 32 + e] = tot; sh[768 + p * 32 + e] = before; }
    __syncthreads();
    if (F.tid < 32) { int tot = 0, before = 0;
#pragma unroll
        for (int p = 0; p < 16; ++p) { tot += sh[256 + p * 32 + F.tid]; before += sh[768 + p * 32 + F.tid]; }
        sh[F.tid] = tot; sh[32 + F.tid] = before; sh[64 + F.tid] = 0; }
    __syncthreads();
    if (F.tid == 0) { int s = 0; for (int e = 0; e < 32; ++e) { sh[96 + e] = s; s += sh[e]; } sh[128] = s; }
    __syncthreads();
    if (F.tid < 32) sh[32 + F.tid] += sh[96 + F.tid];
    if (F.vcu == 0 && F.tid < 32) {
        int* tiles = (int*)(F.ws + WS_TAB + TAB_TILES); const int e = F.tid; int nt = 0;
        for (int e2 = 0; e2 < e; ++e2) nt += (sh[e2] + 255) >> 8;
        const int cnt = sh[e], st = sh[96 + e];
        for (int i = 0; i * 256 < cnt; ++i) { *(v4u*)(tiles + 4 * (nt + i)) = (v4u){(unsigned)e, (unsigned)(st + 256 * i), (unsigned)((cnt - 256 * i) < 256 ? (cnt - 256 * i) : 256), 0u}; }
        if (e == 31) tiles[4 * MAX_TILES] = nt + ((cnt + 255) >> 8);
    }
    __syncthreads();
    const int* tope = (const int*)(F.ws + WS_TAB + TAB_TOPE); const float* topg = (const float*)(F.ws + WS_TAB + TAB_TOPG);
    int* slotof = (int*)(F.ws + WS_TAB + TAB_SLOTOF); int* slottok = (int*)(F.ws + WS_TAB + TAB_SLOTTOK); float* slotg = (float*)(F.ws + WS_TAB + TAB_SLOTG);
    { const int a = F.vcu * 512 + F.tid;
      const int e = tope[a]; const float gt = topg[a];
      const int pos = __hip_atomic_fetch_add((LAS int*)sh + 64 + e, 1, __ATOMIC_RELAXED, __HIP_MEMORY_SCOPE_WORKGROUP);
      const int slot = sh[32 + e] + pos;
      slotof[a] = slot; slottok[slot] = a >> 2; slotg[slot] = gt; }
}

__device__ __forceinline__ void p10_combine(Frame& F, const float* g_final, float* outp) {
    const int gw = F.vcu * NWAVES + F.wave, NGW = F.G * NWAVES;
    const int* slotof = (const int*)(F.ws + WS_TAB + TAB_SLOTOF);
    const unsigned char* Y1 = F.ws + WS_Y;
    f32x4 gg[4];
#pragma unroll
    for (int j = 0; j < 4; ++j) gg[j] = *((const f32x4*)g_final + F.lane + 64 * j);
    const int myslot = slotof[(gw + (F.lane >> 2) * NGW) * 4 + (F.lane & 3)];
    for (int k = 0; k < T_TOK / (NWAVES * 256); k += 2) {
        f32x4 v[2][4]; int sl[2][4];
#pragma unroll
        for (int q = 0; q < 2; ++q) { const int t = gw + (k + q) * NGW;
#pragma unroll
            for (int r = 0; r < 4; ++r) sl[q][r] = __shfl(myslot, (k + q) * 4 + r);
#pragma unroll
            for (int j = 0; j < 4; ++j) { typedef unsigned u32x2_ __attribute__((ext_vector_type(2))); const u32x2_ w = __builtin_nontemporal_load((const u32x2_*)((const bf16*)(F.ws + WS_WD) + (size_t)t * D_MODEL) + F.lane + 64 * j);
                v[q][j] = (f32x4){bflo(w.x), bfhi(w.x), bflo(w.y), bfhi(w.y)}; } }
#pragma unroll
        for (int q = 0; q < 2; ++q)
#pragma unroll
            for (int r = 0; r < 4; ++r) { const unsigned char* yp = Y1 + (size_t)sl[q][r] * 1024;
#pragma unroll
                for (int j = 0; j < 4; ++j) { const int w = __builtin_nontemporal_load((const int*)yp + F.lane + 64 * j); typedef float f2_ __attribute__((ext_vector_type(2)));
                    const f2_ lo = __builtin_amdgcn_cvt_pk_f32_fp8(w, false), hi = __builtin_amdgcn_cvt_pk_f32_fp8(w, true);
                    v[q][j].x += lo.x * YSCALE_INV; v[q][j].y += lo.y * YSCALE_INV; v[q][j].z += hi.x * YSCALE_INV; v[q][j].w += hi.y * YSCALE_INV; } }
#pragma unroll
        for (int q = 0; q < 2; ++q) { const int t = gw + (k + q) * NGW; float s = 0.f;
#pragma unroll
            for (int j = 0; j < 4; ++j) s += (v[q][j].x * v[q][j].x + v[q][j].y * v[q][j].y) + (v[q][j].z * v[q][j].z + v[q][j].w * v[q][j].w);
            const float rstd = 1.f / sqrtf(wave_sum(s) * (1.f / D_MODEL) + NORM_EPS);
#pragma unroll
            for (int j = 0; j < 4; ++j) __builtin_nontemporal_store(v[q][j] * rstd * gg[j], (f32x4*)(outp + (size_t)t * D_MODEL) + F.lane + 64 * j); }
    }
}
__device__ __forceinline__ rw::Bufs make_bufs(Frame& F) {
    rw::Bufs B; bf16* gu = (bf16*)(F.ws + WS_GU); bf16* wd = (bf16*)(F.ws + WS_WD); const size_t AS = (size_t)T_TOK * 512;
    B.KK = gu; B.BT = gu + AS; B.KT = gu + 2 * AS; B.RT = gu + 3 * AS; B.V = wd; B.G = wd + AS;
    B.McT = (bf16*)F.out; B.gamC = (float*)(F.ws + WS_RW); B.bonus = (float*)(F.ws + WS_TAB + TAB_BONUS);
    B.GcT = F.out; B.U0d = (unsigned*)((unsigned char*)F.out + 64 * MiB); B.S0 = (bf16*)((unsigned char*)F.out + 96 * MiB);
    return B;
}
__global__ void __launch_bounds__(NTHREADS, 2) fwd_kernel(Args args) {
    extern __shared__ __attribute__((aligned(16))) unsigned char lds[];
    Frame F;
    F.lds = (LAS unsigned char*)lds;
    F.MISC = (volatile LAS unsigned*)(F.lds + MISC_OFF);
    F.tid = threadIdx.x; F.lane = F.tid & 63; F.wave = __builtin_amdgcn_readfirstlane(F.tid >> 6);
    F.G = gridDim.x; { const int bx = blockIdx.x; F.vcu = (F.G % 8 == 0) ? (bx % 8) * (F.G / 8) + bx / 8 : bx; }
    F.ws = args.ws; F.out = args.out; F.ctl = (unsigned*)(args.ws + WS_CTL);
    for (int u = F.tid; u < (LDS_BYTES - LDSCTL_OFF) / 4; u += NTHREADS) ((LAS unsigned*)(F.lds + LDSCTL_OFF))[u] = 0u;
    __syncthreads();
#ifndef REPLAY_FROM
#define REPLAY_FROM -1
#endif
    int lo = args.ph_lo, hi = args.ph_hi & 255; const int pflags = args.ph_hi >> 8;
#if REPLAY_FROM > 6
    hi = 13;
#endif
    XcdBarrier bar; bar.bar = F.ctl + 4096; bar.x = 0; bar.st = nullptr;
    if (hi - lo > 1) bar = xcd_barrier_post(F.ctl + 4096, F.MISC + 8);
#ifndef REPMASK
#define REPMASK 0
#endif
#define IN(k) (lo <= (k) && (k) < hi)
#define REP(k) (((REPMASK >> (k)) & 1) != 0)
#define SEAM(k) do { if (IN(k) && IN((k) + 1)) xcd_barrier(bar); } while (0)
    const float* x = args.in[0];
    const int* tiles = (const int*)(F.ws + WS_TAB + TAB_TILES);
#ifndef REPBMASK
#define REPBMASK 0
#endif
#define REPB(k) (((REPBMASK >> (k)) & 1) != 0)
#define RUN(k, BODY) do { if (IN(k)) { BODY if (REP(k)) { __syncthreads(); BODY } if (REPB(k)) { xcd_barrier(bar); BODY } } } while (0)
#define B0 { p0_prologue(F, x, args.in[1], args.in[2], args.in[15]); p6_router_images(F, args.in[16], args.in[17]); }
#define B1 { pg8::Gemm g{(const pg8::bf16_t*)(F.ws + WS_BB), (const pg8::bf16_t*)(F.ws + WS_WIN), 1024, 2048}; pg8::DenseOrder S; S.init(T_TOK, INW_PAD, F.G, (int)blockIdx.x); \
        EpiProj E{(bf16*)(F.ws + WS_PROJ), INW_PAD}; pg8::gemm_phase<EpiProj, pg8::DenseOrder, false>(F.lds + RING_OFF, g, S, E); \
        if ((int)blockIdx.x >= (T_TOK / 256) * (INW_PAD / 256) - 6 * 256) {        \
            for (int it = F.wave; it < 32; it += NWAVES) conv_wdown_item(args.in[23], F.ws + WS_WDF, F.vcu * 32 + it, F.lane); if (F.tid == 0) F.MISC[23] = 1u; } }
#define B2 { p2_qkstats(F, F.ctl + 2048); const rw::Bufs B = make_bufs(F); p2_rwkv_prep2(F, args.in[4], args.in[5], args.in[6], args.in[7], args.in[8], args.in[9], args.in[10], args.in[11], args.in[12], B, REP(16) ? 2 : 1); }
#ifndef CONV_STOP_AT_R1
#define CONV_STOP_AT_R1 0
#endif
#define CONV_GU_NEXT(itv) { int it_ = 0; if (F.lane == 0) it_ = (int)__hip_atomic_fetch_add((LAS unsigned*)(F.MISC + 20), 1u, __ATOMIC_RELAXED, __HIP_MEMORY_SCOPE_WORKGROUP); itv = __builtin_amdgcn_readfirstlane(it_); }
#define B3 { const rw::Bufs B = make_bufs(F); asm volatile("s_waitcnt vmcnt(0)" ::: "memory"); __syncthreads(); __builtin_amdgcn_fence(__ATOMIC_ACQUIRE, "agent"); asm volatile("s_waitcnt vmcnt(0)" ::: "memory"); \
        if (F.wave < 4) { if (!(pflags & 1)) { const int ub_ = (F.vcu >> 5) * 512 + (F.vcu & 31) * 2 + (F.wave & 1) + (F.wave >> 1) * 64; \
            for (int u = ub_; u < ub_ + 512; u += 128) { \
                if (REP(17)) rw::r1_chunk<true>(u, B, (rw::lds_ptr)(F.lds + RING_OFF + F.wave * 32768)); rw::r1_chunk<false>(u, B, (rw::lds_ptr)(F.lds + RING_OFF + F.wave * 32768)); } \
            } if (F.lane == 0) __hip_atomic_fetch_add((LAS unsigned*)(F.MISC + 21), 1u, __ATOMIC_RELAXED, __HIP_MEMORY_SCOPE_WORKGROUP); } \
        else if (!(pflags & 2)) { if (F.MISC[23] == 0u) { for (int it = (F.vcu * 4 + F.wave - 4) * 8; it < (F.vcu * 4 + F.wave - 4) * 8 + 8; ++it) conv_wdown_item(args.in[23], F.ws + WS_WDF, it, F.lane); } \
            for (;;) { if (F.MISC[21] >= 4u && !(pflags & 4) && CONV_STOP_AT_R1) break; int it; CONV_GU_NEXT(it) if (it >= 64) break; conv_gu_item(args.in[19], args.in[21], F.ws + WS_GUF, F.vcu * 64 + it, F.lane); } } }
#ifndef P4_SPLIT
#define P4_SPLIT 0
#endif
#ifndef R2_SHADOW_CONV
#define R2_SHADOW_CONV 0
#endif
#define B4A { const rw::Bufs B = make_bufs(F); if ((blockIdx.x & 8) == 0) { \
        { const int x_ = (int)blockIdx.x & 7, a_ = (int)blockIdx.x >> 4; rw::r2_chain_wg(x_ * 8 + (a_ >> 1), a_ & 1, B, (rw::lds_ptr)(F.lds + RING_OFF), F.wave); } \
        asm volatile("s_waitcnt vmcnt(0)" ::: "memory"); __syncthreads(); \
        if (F.tid == 0) { __builtin_amdgcn_fence(__ATOMIC_RELEASE, "agent"); asm volatile("s_waitcnt vmcnt(0)" ::: "memory"); (void)__hip_atomic_fetch_add(F.ctl + 2304, 1u, __ATOMIC_RELAXED, __HIP_MEMORY_SCOPE_AGENT); } } }
#define B4B { att::attn_phase(F.ctl + 1024 + pass_ * 2048, F.MISC + 16, (const bf16*)(F.ws + WS_PROJ), (const float*)(F.ws + WS_TAB + TAB_KMEAN), F.ctl + 2048, args.in[3], (bf16*)(F.ws + WS_PROJ) + XR_OFF, (char*)lds + RING_OFF); }
#define B4B2 { att::attn_phase(F.ctl + 3072, F.MISC + 16, (const bf16*)(F.ws + WS_PROJ), (const float*)(F.ws + WS_TAB + TAB_KMEAN), F.ctl + 2048, args.in[3], (bf16*)(F.ws + WS_PROJ) + XR_OFF, (char*)lds + RING_OFF); }
#define B4 { B4A if (REP(14)) { B4A } if (P4_SPLIT) xcd_barrier(bar); B4B if (REP(15)) { B4B2 } if (REP(20)) { xcd_barrier(bar); if (F.tid == 0) F.MISC[22] = 0u; __syncthreads(); B4A B4B2 } }
#define B5 { const rw::Bufs B = make_bufs(F); \
        if (F.tid == 0) { unsigned sp_ = 0; while (__hip_atomic_load(F.ctl + 2304, __ATOMIC_RELAXED, __HIP_MEMORY_SCOPE_AGENT) < 128u) { __builtin_amdgcn_s_sleep(2); if (++sp_ > (1u << 24)) break; } \
            __builtin_amdgcn_fence(__ATOMIC_ACQUIRE, "agent"); asm volatile("s_waitcnt vmcnt(0)" ::: "memory"); } \
        __syncthreads(); \
        if (F.wave < 4) { int kq_ = 0; const int grp_ = (int)blockIdx.x & 7;        \
            for (;;) { int u = -1; if (F.lane == 0) { while (kq_ < 8) { const int q_ = (grp_ + kq_) & 7; const unsigned p_ = __hip_atomic_fetch_add(F.ctl + 2320 + 64 * q_, 1u, __ATOMIC_RELAXED, __HIP_MEMORY_SCOPE_AGENT); if (p_ < 512u) { u = q_ * 512 + (int)p_; break; } ++kq_; } } \
            u = __builtin_amdgcn_readfirstlane(u); if (u < 0) break; \
            rw::r3_chunk(u, B, args.in[13], args.in[14], (bf16*)(F.ws + WS_PROJ) + XR_OFF, (rw::lds_ptr)(F.lds + RING_OFF + F.wave * 32768)); } } \
        for (;;) { int it = 0; if (F.lane == 0) it = (int)__hip_atomic_fetch_add((LAS unsigned*)(F.MISC + 20), 1u, __ATOMIC_RELAXED, __HIP_MEMORY_SCOPE_WORKGROUP); it = __builtin_amdgcn_readfirstlane(it); if (it >= 64) break; \
            conv_gu_item(args.in[19], args.in[21], F.ws + WS_GUF, F.vcu * 64 + it, F.lane); } \
        if (REP(19)) { __syncthreads(); if (F.tid == 0) F.MISC[20] = 0u; __syncthreads(); \
        for (;;) { int it = 0; if (F.lane == 0) it = (int)__hip_atomic_fetch_add((LAS unsigned*)(F.MISC + 20), 1u, __ATOMIC_RELAXED, __HIP_MEMORY_SCOPE_WORKGROUP); it = __builtin_amdgcn_readfirstlane(it); if (it >= 64) break; \
            conv_gu_item(args.in[19], args.in[21], F.ws + WS_GUF, F.vcu * 64 + it, F.lane); } } }
#define B6 { pg8::Gemm g{(const pg8::bf16_t*)(F.ws + WS_PROJ) + XR_OFF, (const pg8::bf16_t*)(F.ws + WS_WOUT), 1024, INW_PAD * 2}; pg8::DenseOrder S; S.init(T_TOK, 1024, F.G, (int)blockIdx.x); \
        EpiResid E{x, (bf16*)(F.ws + WS_WD)}; pg8::gemm_phase<EpiResid, pg8::DenseOrder, false>(F.lds + RING_OFF, g, S, E); }
#define B7 { }
#define B8 { p6_router(F, args.in[16], args.in[17], args.in[18]); }
#define B9 { p7_scatter(F); }
#define B10 { const int ntiles = __hip_atomic_load(tiles + 4 * MAX_TILES, RLX_AGENT); pg8::Gemm g{(const pg8::bf16_t*)F.out, (const pg8::bf16_t*)(F.ws + WS_GUF), 1024, 1024}; \
        MoeOrder S{tiles, 0, ntiles, 8, F.G, (int)blockIdx.x, (const int*)(F.ws + WS_TAB + TAB_SLOTTOK), 2048}; LAS unsigned short* btab = (LAS unsigned short*)(F.lds + LDSCTL_OFF + 6144); \
        { LAS int* ud_ = (LAS int*)(F.lds + LDSCTL_OFF + 15360);           \
          if (F.tid < 32) { int e_, r0_, cn_, oc_; S.desc(F.tid, e_, r0_, cn_, oc_); ud_[F.tid * 4] = e_; ud_[F.tid * 4 + 1] = oc_; ud_[F.tid * 4 + 2] = r0_; ud_[F.tid * 4 + 3] = cn_; } __syncthreads(); \
          if (F.tid < 256) { _Pragma("unroll") for (int i = 0; i < 17; ++i) { if (ud_[i * 4 + 3] >= 0) { const float* bsrc = (F.tid < 128 ? args.in[20] : args.in[22]) + (size_t)ud_[i * 4] * 1024 + ud_[i * 4 + 1] + (F.tid & 127); btab[i * 256 + F.tid] = (unsigned short)f2bf(*bsrc); } } } __syncthreads(); } \
        MoeOrderL<8> SL{(const LAS int*)(F.lds + LDSCTL_OFF + 15360), (const int*)(F.ws + WS_TAB + TAB_SLOTTOK), 2048}; EpiGlu E{F.ws + WS_H, btab}; pg8::gemm_phase<EpiGlu, MoeOrderL<8>, true, true>(F.lds + RING_OFF, g, SL, E); }
#define B11 { const int ntiles = __hip_atomic_load(tiles + 4 * MAX_TILES, RLX_AGENT); \
        MoeOrder S{tiles, 0, ntiles, 4, F.G, (int)blockIdx.x, nullptr, 1024}; LAS float* gtab = (LAS float*)(F.lds + LDSCTL_OFF + 1024); LAS unsigned short* bdtab = (LAS unsigned short*)(F.lds + LDSCTL_OFF + 10240); \
        { LAS int* ud_ = (LAS int*)(F.lds + LDSCTL_OFF + 15360); const float* sg_ = (const float*)(F.ws + WS_TAB + TAB_SLOTG); \
          if (F.tid < 32) { int e_, r0_, cn_, oc_; S.desc(F.tid, e_, r0_, cn_, oc_); ud_[F.tid * 4] = e_; ud_[F.tid * 4 + 1] = oc_; ud_[F.tid * 4 + 2] = r0_; ud_[F.tid * 4 + 3] = cn_; } __syncthreads(); \
          if (F.tid < 256) { _Pragma("unroll") for (int i = 0; i < 9; ++i) { const int cn_ = ud_[i * 4 + 3]; if (cn_ >= 0) { gtab[i * 256 + F.tid] = (F.tid < cn_) ? sg_[ud_[i * 4 + 2] + F.tid] : 0.f; bdtab[i * 256 + F.tid] = (unsigned short)f2bf(args.in[24][(size_t)ud_[i * 4] * 1024 + ud_[i * 4 + 1] + F.tid]); } } } __syncthreads(); } \
        pg8::Gemm g{(const pg8::bf16_t*)(F.ws + WS_H), (const pg8::bf16_t*)(F.ws + WS_WDF), 1024, 1024}; EpiDown E{F.ws + WS_Y, bdtab, gtab}; \
        MoeOrderL<4> SL{(const LAS int*)(F.lds + LDSCTL_OFF + 15360), nullptr, 1024}; pg8::gemm_phase<EpiDown, MoeOrderL<4>, false, true>(F.lds + RING_OFF, g, SL, E); }
#define B12 { }
#define B13 { if (REP(18)) { p10_combine(F, args.in[25], (float*)(F.ws + WS_H + 112 * MiB)); __syncthreads(); } p10_combine(F, args.in[25], F.out); }
#define pass_ 0
    RUN(0, B0); SEAM(0); RUN(1, B1); SEAM(1); RUN(2, B2); RUN(3, B3); SEAM(3); RUN(4, B4); __syncthreads(); RUN(5, B5); SEAM(5); RUN(6, B6); RUN(7, B7); SEAM(7); RUN(8, B8); SEAM(8); RUN(9, B9); SEAM(9); RUN(10, B10); SEAM(10); RUN(11, B11); SEAM(12); RUN(13, B13);
#undef pass_
#if REPLAY_FROM >= 0
    xcd_barrier(bar); if (F.tid == 0) F.MISC[20] = 0u; __syncthreads(); lo = REPLAY_FROM; hi = 14;
#define pass_ 1
    RUN(0, B0); SEAM(0); RUN(1, B1); SEAM(1); RUN(2, B2); RUN(3, B3); SEAM(3); RUN(4, B4); __syncthreads(); RUN(5, B5); SEAM(5); RUN(6, B6); RUN(7, B7); SEAM(7); RUN(8, B8); SEAM(8); RUN(9, B9); SEAM(9); RUN(10, B10); SEAM(10); RUN(11, B11); SEAM(12); RUN(13, B13);
#undef pass_
#endif
#undef IN
#undef SEAM
}

extern "C" void kernel_launch(void* const* d_in, const int* in_sizes, int n_in, void* d_out, int out_size, void* d_ws, size_t ws_size, hipStream_t stream) {
    static int grid = 0;
    if (grid == 0) {
        if (n_in != 26 || out_size != T_TOK * D_MODEL || ws_size < WS_END) { fprintf(stderr, "kernel_launch: unexpected shapes n_in %d out %d ws %zu (need %zu)\n", n_in, out_size, ws_size, (size_t)WS_END); grid = -1; return; }
        int dev = 0, cus = 0;
        if (hipGetDevice(&dev) != hipSuccess || hipDeviceGetAttribute(&cus, hipDeviceAttributeMultiprocessorCount, dev) != hipSuccess) { grid = -1; return; }
        if (hipFuncSetAttribute((const void*)fwd_kernel, hipFuncAttributeMaxDynamicSharedMemorySize, LDS_BYTES) != hipSuccess) { fprintf(stderr, "kernel_launch: hipFuncSetAttribute failed\n"); grid = -1; return; }
        (void)hipGetLastError();
        grid = cus;
        if (grid != 256) { fprintf(stderr, "kernel_launch: %d CUs, need 256\n", grid); grid = -1; return; }
    }
    if (grid < 0) return;
    (void)hipMemsetAsync((char*)d_ws + WS_CTL, 0, CTL_ZERO_BYTES, stream);
    Args a{};
    for (int i = 0; i < 26; ++i) a.in[i] = (const float*)d_in[i];
    a.out = (float*)d_out; a.ws = (unsigned char*)d_ws;
#ifdef PREK
#ifndef PREFLAGS
#define PREFLAGS 0
#endif
    a.ph_lo = 0; a.ph_hi = PREK | (PREFLAGS << 8);
    hipLaunchKernelGGL(fwd_kernel, dim3(grid), dim3(NTHREADS), LDS_BYTES, stream, a);
    (void)hipMemsetAsync((char*)d_ws + WS_CTL, 0, CTL_ZERO_BYTES, stream);
#endif
    a.ph_lo = 0; a.ph_hi = 14;
    hipLaunchKernelGGL(fwd_kernel, dim3(grid), dim3(NTHREADS), LDS_BYTES, stream, a);
}
```
